# Optimizing an MI355X kernel written in HIP

```python
import jax, jax.numpy as jnp
from jax import lax
import numpy as np


D_MODEL = 2048
BATCH = 4
SEQ = 2048
DEPTH = 2

D_MIX = D_MODEL
RWKV_W = 3 * D_MIX // 8
RET_W = D_MIX // 4
GDN_W = D_MIX - RWKV_W - RET_W
RWKV_HEAD_DIM = 64
RET_HEAD_DIM = 128
GDN_HEAD_DIM = 128
RWKV_HEADS = RWKV_W // RWKV_HEAD_DIM
RET_HEADS = RET_W // RET_HEAD_DIM
GDN_HEADS = GDN_W // GDN_HEAD_DIM
RWKV_DECAY_RANK = 96
RWKV_A_RANK = 96
RWKV_VRES_RANK = 64
RWKV_DECAY_SCALE = 0.6065306597126334
RWKV_GN_EPS = 64e-5
RET_CHUNK = 128
RET_GN_EPS = 1e-5
ROPE_BASE = 10000.0
GDN_CONV = 4
GDN_CHUNK = 64
MOE_GROUPS = 4
MOE_EXPERTS_PER_GROUP = 8
MOE_EXPERTS = MOE_GROUPS * MOE_EXPERTS_PER_GROUP
MOE_TOP_K = 2
MOE_HIDDEN = D_MODEL // 8
NORM_EPS = 1e-6
IN_SPLITS = (RWKV_W,) * 4 + (RET_W,) * 4 + (GDN_W,) * 4 + (GDN_HEADS,) * 2
N_IN = sum(IN_SPLITS)

kernel_name = "hybrid_rwkv7_retnet_gdn_hmoe"


def _rms_norm(x, w, eps=NORM_EPS):
    xf = x.astype(jnp.float32)
    y = xf * lax.rsqrt(jnp.mean(xf * xf, axis=-1, keepdims=True) + eps)
    return (y * w.astype(jnp.float32)).astype(x.dtype)


def _token_shift(x):
    pad = [(0, 0)] * x.ndim
    pad[1] = (1, 0)
    return jnp.pad(x[:, :-1], pad)


def _split_heads(t, n_heads):
    return t.reshape(*t.shape[:-1], n_heads, t.shape[-1] // n_heads)


def _l2norm(t, eps=1e-6):
    return t * lax.rsqrt(jnp.sum(t * t, axis=-1, keepdims=True) + eps)


def _head_norm(t, eps):
    mu = jnp.mean(t, axis=-1, keepdims=True)
    var = jnp.mean(jnp.square(t - mu), axis=-1, keepdims=True)
    y = (t - mu) * lax.rsqrt(var + eps)
    return y.reshape(*t.shape[:-2], -1)


def _to_chunks(t, c):
    b, s = t.shape[:2]
    return t.reshape(b, s // c, c, *t.shape[2:]).swapaxes(2, 3)


def _from_chunks(t):
    t = t.swapaxes(2, 3)
    return t.reshape(t.shape[0], -1, *t.shape[3:])


def _rwkv7_recurrence(r, w, k, v, kk, a):
    b, s, h, n = r.shape

    def step(state, inp):
        r_t, w_t, k_t, v_t, kk_t, a_t = inp
        sa = jnp.einsum('bhvk,bhk->bhv', state, -kk_t)
        state = (state * w_t[:, :, None, :]
                 + sa[..., None] * (kk_t * a_t)[:, :, None, :]
                 + v_t[..., None] * k_t[:, :, None, :])
        return state, jnp.einsum('bhvk,bhk->bhv', state, r_t)

    xs = tuple(jnp.moveaxis(t, 1, 0) for t in (r, w, k, v, kk, a))
    _, o = lax.scan(step, jnp.zeros((b, h, n, n), jnp.float32), xs)
    return jnp.moveaxis(o, 0, 1)


def _rwkv7_mix(h, r, k, v, g, mu_rkvg, mu_wa, w0, w1, w2, a0, a1, a2, k_k, k_a, r_k,
               ln_w, ln_b, v_first, vres):
    f32 = jnp.float32
    p = jnp.stack([r, k, v, g], axis=2).astype(f32)
    p = p + (_token_shift(p) - p) * mu_rkvg
    r, k, v, g = p[:, :, 0], p[:, :, 1], p[:, :, 2], p[:, :, 3]
    hf = h.astype(f32)
    dh = _token_shift(hf) - hf
    xw = hf + dh * mu_wa[0]
    xa = hf + dh * mu_wa[1]
    log_w = -RWKV_DECAY_SCALE * jax.nn.sigmoid(w0 + jnp.tanh(xw @ w1) @ w2)
    a = jax.nn.sigmoid(a0 + (xa @ a1) @ a2)
    if vres is None:
        v_first = v
    else:
        mu_v, v0, v1, v2 = vres
        xv = hf + dh * mu_v
        v = v + (v_first - v) * jax.nn.sigmoid(v0 + (xv @ v1) @ v2)
    kk = _l2norm(_split_heads(k * k_k, RWKV_HEADS))
    k = k * (1.0 + (a - 1.0) * k_a)
    r_h, k_h, v_h, a_h, w_h = (_split_heads(t, RWKV_HEADS) for t in (r, k, v, a, jnp.exp(log_w)))
    o = _rwkv7_recurrence(r_h, w_h, k_h, v_h, kk, a_h)
    o = _head_norm(o, RWKV_GN_EPS) * ln_w + ln_b
    bonus = (jnp.sum(r_h * k_h * r_k, axis=-1, keepdims=True) * v_h).reshape(o.shape)
    return (o + bonus) * jax.nn.sigmoid(g), v_first


def _rotary(t, positions):
    d = t.shape[-1]
    inv_freq = ROPE_BASE ** (-jnp.arange(0, d, 2, dtype=jnp.float32) / d)
    ang = positions.astype(jnp.float32)[..., None] * inv_freq
    cos = jnp.cos(ang)[:, :, None, :]
    sin = jnp.sin(ang)[:, :, None, :]
    t1, t2 = t[..., : d // 2], t[..., d // 2:]
    return jnp.concatenate([t1 * cos - t2 * sin, t1 * sin + t2 * cos], axis=-1)


def _retention_chunked(q, k, v, log_gamma):
    c = RET_CHUNK
    b, _, h, dk = q.shape
    dv = v.shape[-1]
    q, k, v = (_to_chunks(t, c) for t in (q, k, v))
    idx = jnp.arange(c, dtype=jnp.float32)
    diff = idx[:, None] - idx[None, :]
    dmask = jnp.where(diff >= 0, jnp.exp(jnp.maximum(diff, 0.0) * log_gamma[:, None, None]), 0.0)
    scores = jnp.einsum('bnhid,bnhjd->bnhij', q, k) * dmask
    inner = jnp.einsum('bnhij,bnhjv->bnhiv', scores, v)
    kdec = k * jnp.exp((c - 1 - idx) * log_gamma[:, None])[:, :, None]
    kv = jnp.einsum('bnhjk,bnhjv->bnhkv', kdec, v)
    chunk_decay = jnp.exp(c * log_gamma)[:, None, None]

    def step(state, kv_n):
        return state * chunk_decay + kv_n, state

    _, r_prev = lax.scan(step, jnp.zeros((b, h, dk, dv), jnp.float32), jnp.moveaxis(kv, 1, 0))
    r_prev = jnp.moveaxis(r_prev, 0, 1)
    qdec = q * jnp.exp((idx + 1.0) * log_gamma[:, None])[:, :, None]
    cross = jnp.einsum('bnhik,bnhkv->bnhiv', qdec, r_prev)
    return _from_chunks(inner + cross)


def _retnet_mix(q, k, v, g, positions, gn_w):
    f32 = jnp.float32
    q = _rotary(_split_heads(q.astype(f32), RET_HEADS), positions)
    k = _rotary(_split_heads(k.astype(f32), RET_HEADS), positions) * RET_HEAD_DIM ** -0.5
    v = _split_heads(v.astype(f32), RET_HEADS)
    log_gamma = jnp.log(1.0 - 2.0 ** (-5.0 - jnp.arange(RET_HEADS, dtype=f32)))
    y = _retention_chunked(q, k, v, log_gamma)
    y = _head_norm(y, RET_GN_EPS) * gn_w
    return jax.nn.silu(g.astype(f32)) * y


def _causal_depthwise_conv(x, w):
    kw, c = w.shape
    return lax.conv_general_dilated(x, w[:, None, :].astype(x.dtype), window_strides=(1,),
                                    padding=[(kw - 1, 0)], dimension_numbers=('NWC', 'WIO', 'NWC'),
                                    feature_group_count=c)


def _gated_delta_chunked(q, k, v, g, beta):
    c = GDN_CHUNK
    q, k, v, g, beta = (_to_chunks(t, c) for t in (q, k, v, g, beta))
    b, _, h, _, dk = q.shape
    dv = v.shape[-1]
    gc = jnp.cumsum(g, axis=-1)
    causal = jnp.tril(jnp.ones((c, c), bool))
    strict = jnp.tril(jnp.ones((c, c), bool), -1)
    decay = jnp.exp(jnp.where(causal, gc[..., :, None] - gc[..., None, :], -jnp.inf))
    kb = k * beta[..., None]
    lower = jnp.where(strict, jnp.einsum('bnhid,bnhjd->bnhij', kb, k) * decay, 0.0)
    rhs = jnp.concatenate([v * beta[..., None], kb * jnp.exp(gc)[..., None]], axis=-1)
    sol = lax.linalg.triangular_solve(lower + jnp.eye(c, dtype=lower.dtype), rhs,
                                      left_side=True, lower=True, unit_diagonal=True)
    u, w = sol[..., :dv], sol[..., dv:]
    attn = jnp.einsum('bnhid,bnhjd->bnhij', q, k) * decay
    g_last = gc[..., -1]
    qg = q * jnp.exp(gc)[..., None]
    kd = k * jnp.exp(g_last[..., None] - gc)[..., None]

    def step(state, inp):
        qg_n, kd_n, u_n, w_n, attn_n, gl_n = inp
        v_new = u_n - jnp.einsum('bhck,bhkv->bhcv', w_n, state)
        o = jnp.einsum('bhck,bhkv->bhcv', qg_n, state) + jnp.einsum('bhij,bhjv->bhiv', attn_n, v_new)
        state = state * jnp.exp(gl_n)[..., None, None] + jnp.einsum('bhck,bhcv->bhkv', kd_n, v_new)
        return state, o

    xs = tuple(jnp.moveaxis(t, 1, 0) for t in (qg, kd, u, w, attn, g_last))
    _, o = lax.scan(step, jnp.zeros((b, h, dk, dv), jnp.float32), xs)
    return _from_chunks(jnp.moveaxis(o, 0, 1))


def _gdn_mix(q, k, v, z, a, b, conv_w, a_log, dt_bias, norm_w):
    f32 = jnp.float32
    qkv = jnp.concatenate([q, k, v], axis=-1).astype(f32)
    qkv = jax.nn.silu(_causal_depthwise_conv(qkv, conv_w.astype(f32)))
    q, k, v = jnp.split(qkv, 3, axis=-1)
    q = _l2norm(_split_heads(q, GDN_HEADS)) * GDN_HEAD_DIM ** -0.5
    k = _l2norm(_split_heads(k, GDN_HEADS))
    v = _split_heads(v, GDN_HEADS)
    beta = jax.nn.sigmoid(b.astype(f32))
    g = -jnp.exp(a_log.astype(f32)) * jax.nn.softplus(a.astype(f32) + dt_bias)
    o = _gated_delta_chunked(q, k, v, g, beta)
    o = (o * lax.rsqrt(jnp.mean(o * o, axis=-1, keepdims=True) + NORM_EPS)).reshape(*o.shape[:-2], -1)
    return o * norm_w * jax.nn.silu(z.astype(f32))


def _hier_moe(x, group_w, group_b, expert_w, expert_b, w1, w3, w2):
    f32 = jnp.float32
    b, s, d = x.shape
    xt = x.reshape(b * s, d)
    group_logits = (xt @ group_w + group_b).astype(f32)
    group_probs = jax.nn.softmax(group_logits, axis=-1)
    group_idx = jnp.argmax(group_logits, axis=-1)
    group_gate = jnp.take_along_axis(group_probs, group_idx[:, None], axis=-1)
    expert_logits = (xt @ expert_w + expert_b).astype(f32).reshape(-1, MOE_GROUPS, MOE_EXPERTS_PER_GROUP)
    in_group = jnp.take_along_axis(expert_logits, group_idx[:, None, None], axis=1)[:, 0]
    top_p, top_i = lax.top_k(jax.nn.softmax(in_group, axis=-1), MOE_TOP_K)
    top_p = top_p / jnp.sum(top_p, axis=-1, keepdims=True)
    within = jnp.sum(top_p[..., None] * jax.nn.one_hot(top_i, MOE_EXPERTS_PER_GROUP, dtype=f32), axis=-2)
    gates = (group_gate * jax.nn.one_hot(group_idx, MOE_GROUPS, dtype=f32))[:, :, None] * within[:, None, :]
    gates = gates.reshape(-1, MOE_EXPERTS).astype(x.dtype)
    hid = jax.nn.silu(jnp.einsum('td,edf->tef', xt, w1)) * jnp.einsum('td,edf->tef', xt, w3)
    y = jnp.einsum('tef,efd->td', hid * gates[..., None], w2)
    return y.reshape(b, s, d)


def setup_inputs(seed: int = 0) -> dict:
    key = jax.random.key(seed)
    keys = iter(jax.random.split(key, 40))
    f32 = jnp.float32

    def nrm(shape, scale):
        return scale * jax.random.normal(next(keys), shape, f32)

    def uni(shape, lo, hi):
        return jax.random.uniform(next(keys), shape, f32, lo, hi)

    L, Lv, D = DEPTH, DEPTH - 1, D_MODEL
    x = nrm((BATCH, SEQ, D), 1.0)
    offset = jax.random.randint(next(keys), (BATCH, 1), 0, 4096, dtype=jnp.int32)
    positions = (offset + jnp.arange(SEQ, dtype=jnp.int32)[None, :]).astype(jnp.int32)
    dt = jnp.exp(uni((L, GDN_HEADS), float(np.log(1e-3)), float(np.log(1e-1))))
    gdn_dt_bias = dt + jnp.log(-jnp.expm1(-dt))
    gdn_a_log = jnp.log(uni((L, GDN_HEADS), 1.0, 16.0))
    return {
        'x': x,
        'positions': positions,
        'norm1_w': 1.0 + nrm((L, D), 0.02),
        'w_in': nrm((L, D, N_IN), D ** -0.5),
        'w_out': nrm((L, D_MIX, D), D_MIX ** -0.5),
        'rwkv_mu_rkvg': uni((L, 4, RWKV_W), 0.0, 1.0),
        'rwkv_mu_wa': uni((L, 2, D), 0.0, 1.0),
        'rwkv_w0': uni((L, RWKV_W), -2.0, 2.0),
        'rwkv_w1': nrm((L, D, RWKV_DECAY_RANK), D ** -0.5),
        'rwkv_w2': nrm((L, RWKV_DECAY_RANK, RWKV_W), 0.5 * RWKV_DECAY_RANK ** -0.5),
        'rwkv_a0': nrm((L, RWKV_W), 0.5),
        'rwkv_a1': nrm((L, D, RWKV_A_RANK), D ** -0.5),
        'rwkv_a2': nrm((L, RWKV_A_RANK, RWKV_W), 0.5 * RWKV_A_RANK ** -0.5),
        'rwkv_k_k': uni((L, RWKV_W), 0.7, 1.0),
        'rwkv_k_a': uni((L, RWKV_W), 0.8, 1.2),
        'rwkv_r_k': nrm((L, RWKV_HEADS, RWKV_HEAD_DIM), 0.1),
        'rwkv_ln_w': 1.0 + nrm((L, RWKV_W), 0.02),
        'rwkv_ln_b': nrm((L, RWKV_W), 0.02),
        'rwkv_mu_vres': uni((Lv, D), 0.0, 1.0),
        'rwkv_v0': nrm((Lv, RWKV_W), 0.5),
        'rwkv_v1': nrm((Lv, D, RWKV_VRES_RANK), D ** -0.5),
        'rwkv_v2': nrm((Lv, RWKV_VRES_RANK, RWKV_W), 0.5 * RWKV_VRES_RANK ** -0.5),
        'ret_gn_w': 1.0 + nrm((L, RET_W), 0.02),
        'gdn_conv_w': nrm((L, GDN_CONV, 3 * GDN_W), GDN_CONV ** -0.5),
        'gdn_a_log': gdn_a_log,
        'gdn_dt_bias': gdn_dt_bias,
        'gdn_norm_w': 1.0 + nrm((L, GDN_W), 0.02),
        'norm2_w': 1.0 + nrm((L, D), 0.02),
        'moe_group_w': nrm((L, D, MOE_GROUPS), D ** -0.5),
        'moe_group_b': nrm((L, MOE_GROUPS), 0.01),
        'moe_expert_w': nrm((L, D, MOE_EXPERTS), D ** -0.5),
        'moe_expert_b': nrm((L, MOE_EXPERTS), 0.01),
        'moe_w1': nrm((L, MOE_EXPERTS, D, MOE_HIDDEN), D ** -0.5),
        'moe_w3': nrm((L, MOE_EXPERTS, D, MOE_HIDDEN), D ** -0.5),
        'moe_w2': nrm((L, MOE_EXPERTS, MOE_HIDDEN, D), MOE_HIDDEN ** -0.5),
        'final_norm_w': 1.0 + nrm((D,), 0.02),
    }


def reference(x, positions, norm1_w, w_in, w_out,
              rwkv_mu_rkvg, rwkv_mu_wa, rwkv_w0, rwkv_w1, rwkv_w2, rwkv_a0, rwkv_a1, rwkv_a2,
              rwkv_k_k, rwkv_k_a, rwkv_r_k, rwkv_ln_w, rwkv_ln_b,
              rwkv_mu_vres, rwkv_v0, rwkv_v1, rwkv_v2,
              ret_gn_w, gdn_conv_w, gdn_a_log, gdn_dt_bias, gdn_norm_w,
              norm2_w, moe_group_w, moe_group_b, moe_expert_w, moe_expert_b,
              moe_w1, moe_w3, moe_w2, final_norm_w):
    split_points = np.cumsum(IN_SPLITS)[:-1].tolist()
    v_first = None
    for l in range(DEPTH):
        h = _rms_norm(x, norm1_w[l])
        (rr, rk, rv, rg, tq, tk, tv, tg, dq, dk, dv, dz, da, db) = jnp.split(h @ w_in[l], split_points, axis=-1)
        vres = None if l == 0 else (rwkv_mu_vres[l - 1], rwkv_v0[l - 1], rwkv_v1[l - 1], rwkv_v2[l - 1])
        out_a, v_first = _rwkv7_mix(h, rr, rk, rv, rg, rwkv_mu_rkvg[l], rwkv_mu_wa[l], rwkv_w0[l],
                                    rwkv_w1[l], rwkv_w2[l], rwkv_a0[l], rwkv_a1[l], rwkv_a2[l],
                                    rwkv_k_k[l], rwkv_k_a[l], rwkv_r_k[l], rwkv_ln_w[l], rwkv_ln_b[l],
                                    v_first, vres)
        out_b = _retnet_mix(tq, tk, tv, tg, positions, ret_gn_w[l])
        out_c = _gdn_mix(dq, dk, dv, dz, da, db, gdn_conv_w[l], gdn_a_log[l], gdn_dt_bias[l], gdn_norm_w[l])
        mixed = jnp.concatenate([out_a, out_b, out_c], axis=-1).astype(x.dtype)
        x = x + mixed @ w_out[l]
        x = x + _hier_moe(_rms_norm(x, norm2_w[l]), moe_group_w[l], moe_group_b[l], moe_expert_w[l],
                          moe_expert_b[l], moe_w1[l], moe_w3[l], moe_w2[l])
    return _rms_norm(x, final_norm_w)
```

```cpp
#include <hip/hip_runtime.h>
#include <cstdio>
#include <cstdint>
constexpr int TIDTAB_OFF = 147456;
__device__ __forceinline__ unsigned tid_slot() { const unsigned hw = (unsigned)__builtin_amdgcn_s_getreg((5 << 11) | 4) & 63u;
    unsigned ln; asm volatile("v_mbcnt_lo_u32_b32 %0, -1, 0\n\tv_mbcnt_hi_u32_b32 %0, -1, %0" : "=v"(ln));
    return TIDTAB_OFF + (hw * 64u + ln) * 4u; }
__device__ __forceinline__ int otid() { return *(const __attribute__((address_space(3))) int*)(size_t)tid_slot(); }
namespace pg8 {
#define PG8_LAS __attribute__((address_space(3)))
typedef unsigned short bf16_t;
typedef short bf16x8 __attribute__((ext_vector_type(8)));
typedef float f32x4 __attribute__((ext_vector_type(4)));
typedef unsigned u32x4 __attribute__((ext_vector_type(4)));
constexpr int BM = 256, BK = 64, HALF = 128, HTB = HALF * BK * 2  , STAGE_BYTES = 8 * HTB, NXCD = 8, WGM = 8;

__host__ __device__ __forceinline__ int lds_byte(int r, int c) { const int st = (r >> 4) * 2 + (c >> 5), rr = r & 15, cc = c & 31, ob = rr * 64 + cc * 2; return st * 1024 + (ob ^ (((ob >> 9) & 1) << 5)); }
__host__ __device__ __forceinline__ void stage_rc(int b, int& R, int& C) { const int st = b / 1024, sb = b % 1024, swz = sb ^ (((sb >> 9) & 1) << 5); R = (st >> 1) * 16 + swz / 64; C = (st & 1) * 32 + (swz % 64) / 2; }
__host__ __device__ __forceinline__ int perm32(int rho) { const int n = rho >> 4, i = rho & 15; return 8 * (i >> 2) + 4 * n + (i & 3); }

struct Unit { int pm, pn; };
struct Gemm { const bf16_t* A; const bf16_t* Bt; int M, N, K; };

struct StaticOrder {
    int nM, nN, nwg, G, c;
    __host__ __device__ void init(int M, int N, int G_, int c_) { nM = M / BM; nN = N / BM; nwg = nM * nN; G = G_; c = c_; }
    __host__ __device__ bool next(int i, Unit& u) const {
        const long L = (long)i * G + c; if (L >= nwg) return false;
        int wgid = (int)L; { const int q = nwg / NXCD, r = nwg % NXCD, xcd = wgid % NXCD, off = wgid / NXCD; wgid = (xcd < r ? xcd * (q + 1) : r * (q + 1) + (xcd - r) * q) + off; }
        const int nig = WGM * nN, gid = wgid / nig, fm = gid * WGM, gsz = (nM - fm) < WGM ? (nM - fm) : WGM;
        u.pm = fm + ((wgid % nig) % gsz); u.pn = (wgid % nig) / gsz; return true;
    }
    __device__ __forceinline__ void a_ready(const Unit&) const {}
    __device__ __forceinline__ void done(const Unit&) const {}
};

__device__ __forceinline__ unsigned cvt_pk_bf16(float lo, float hi) { unsigned r; asm volatile("v_cvt_pk_bf16_f32 %0, %1, %2" : "=v"(r) : "v"(lo), "v"(hi)); return r; }
typedef float f32x2 __attribute__((ext_vector_type(2)));
__device__ __forceinline__ f32x2 gelu_pk(f32x2 v) {
    const f32x2 av = __builtin_elementwise_abs(v), d = av * 0.2316418882f + 1.0f;
    f32x2 t; t.x = __builtin_amdgcn_rcpf(d.x); t.y = __builtin_amdgcn_rcpf(d.y);
    f32x2 q = t * 0.5307027145f + (-0.7265760135f); q = q * t + 0.7107068705f; q = q * t + (-0.142248368f); q = q * t + 0.127414796f; q = q * t;
    const f32x2 s = (v * v) * (-0.72134752044f);
    f32x2 e; e.x = __builtin_amdgcn_exp2f(s.x); e.y = __builtin_amdgcn_exp2f(s.y);
    const f32x2 m = v * (q * e), r = v - m;
    f32x2 o; o.x = v.x < 0.f ? m.x : r.x; o.y = v.y < 0.f ? m.y : r.y; return o;
}

template <int ACT  > struct EpiBf16 {
    static constexpr bool PERM = true, AFTER_DRAIN = false; static_assert(ACT == 0 || ACT == 1, "EpiBf16: ACT is 0 (none) or 1 (gelu_pk)");
    bf16_t* O; int ldc; const float* bias; int split_cols; size_t split_stride; float scale0;
    __device__ __forceinline__ void operator()(const f32x4 (&acc)[2][2][4][2], const Unit& u, int wr, int wc, int fr, int fq) const {
        const int row0 = u.pm * BM + wr * 64 + fr; int colt = u.pn * BM; bf16_t* base = O;
        float sc = 1.f; if (split_cols) { const int t = colt / split_cols; base += (size_t)t * split_stride; colt -= t * split_cols; if (t == 0) sc = scale0; }
        const int col0 = colt + wc * 32 + 8 * fq, bcol0 = u.pn * BM + wc * 32 + 8 * fq;
        f32x4 bv[2][2];
#pragma unroll
        for (int bj = 0; bj < 2; ++bj)
#pragma unroll
            for (int n = 0; n < 2; ++n) bv[bj][n] = bias ? *(const f32x4*)(bias + bcol0 + bj * HALF + 4 * n) : (f32x4){0.f, 0.f, 0.f, 0.f};
#pragma unroll
        for (int ai = 0; ai < 2; ++ai)
#pragma unroll
            for (int m = 0; m < 4; ++m) { bf16_t* rowp = base + (size_t)(row0 + ai * HALF + m * 16) * ldc + col0;
#pragma unroll
                for (int bj = 0; bj < 2; ++bj) { f32x4 v0 = acc[ai][bj][m][0] + bv[bj][0], v1 = acc[ai][bj][m][1] + bv[bj][1];
                    if (ACT == 1) { f32x2 a = gelu_pk((f32x2){v0[0], v0[1]}), b = gelu_pk((f32x2){v0[2], v0[3]}), c = gelu_pk((f32x2){v1[0], v1[1]}), d = gelu_pk((f32x2){v1[2], v1[3]});
                        v0 = (f32x4){a.x, a.y, b.x, b.y}; v1 = (f32x4){c.x, c.y, d.x, d.y}; }
                    v0 = v0 * sc; v1 = v1 * sc; u32x4 w; w.x = cvt_pk_bf16(v0[0], v0[1]); w.y = cvt_pk_bf16(v0[2], v0[3]); w.z = cvt_pk_bf16(v1[0], v1[1]); w.w = cvt_pk_bf16(v1[2], v1[3]);
                    *(u32x4*)(rowp + bj * HALF) = w; } }
    }
};

struct EpiResF32 {
    static constexpr bool PERM = false, AFTER_DRAIN = false;
    float* C; const float* R; int ldc;
    __device__ __forceinline__ void operator()(const f32x4 (&acc)[2][2][4][2], const Unit& u, int wr, int wc, int fr, int fq) const {
        const int row0 = u.pm * BM + wr * 64 + fr, col0 = u.pn * BM + wc * 32 + 4 * fq;
#pragma unroll
        for (int ai = 0; ai < 2; ++ai) {
            f32x4 rv[4][2][2];
#pragma unroll
            for (int m = 0; m < 4; ++m) { const size_t ro = (size_t)(row0 + ai * HALF + m * 16) * ldc + col0;
#pragma unroll
                for (int bj = 0; bj < 2; ++bj)
#pragma unroll
                    for (int n = 0; n < 2; ++n) rv[m][bj][n] = *(const f32x4*)(R + ro + bj * HALF + n * 16); }
            asm volatile("s_waitcnt vmcnt(0)" ::: "memory");
#pragma unroll
            for (int m = 0; m < 4; ++m) { const size_t ro = (size_t)(row0 + ai * HALF + m * 16) * ldc + col0;
#pragma unroll
                for (int bj = 0; bj < 2; ++bj)
#pragma unroll
                    for (int n = 0; n < 2; ++n) *(f32x4*)(C + ro + bj * HALF + n * 16) = rv[m][bj][n] + acc[ai][bj][m][n]; } }
    }
};
struct EpiSwiGLU {
    static constexpr bool PERM = true, AFTER_DRAIN = false;
    bf16_t* O; int ldc;
    __device__ __forceinline__ float act(float g, float up) const { return g * up * __builtin_amdgcn_rcpf(1.0f + __expf(-g)); }
    __device__ __forceinline__ void operator()(const f32x4 (&acc)[2][2][4][2], const Unit& u, int wr, int wc, int fr, int fq) const {
        const int row0 = u.pm * BM + wr * 64 + fr, col0 = (u.pn & 1) * HALF + wc * 32 + 8 * fq;
#pragma unroll
        for (int ai = 0; ai < 2; ++ai)
#pragma unroll
            for (int m = 0; m < 4; ++m) { bf16_t* rowp = O + (size_t)(row0 + ai * HALF + m * 16) * ldc + col0;
                const f32x4 g0 = acc[ai][0][m][0], g1 = acc[ai][0][m][1], u0 = acc[ai][1][m][0], u1 = acc[ai][1][m][1];
                u32x4 w; w.x = cvt_pk_bf16(act(g0[0], u0[0]), act(g0[1], u0[1])); w.y = cvt_pk_bf16(act(g0[2], u0[2]), act(g0[3], u0[3]));
                w.z = cvt_pk_bf16(act(g1[0], u1[0]), act(g1[1], u1[1])); w.w = cvt_pk_bf16(act(g1[2], u1[2]), act(g1[3], u1[3]));
                *(u32x4*)rowp = w; }
    }
};
struct EpiBf16Grp {
    static constexpr bool PERM = true, AFTER_DRAIN = false;
    bf16_t* O; int ldc, ntn_mask;
    __device__ __forceinline__ void operator()(const f32x4 (&acc)[2][2][4][2], const Unit& u, int wr, int wc, int fr, int fq) const {
        const int row0 = u.pm * BM + wr * 64 + fr, col0 = (u.pn & ntn_mask) * BM + wc * 32 + 8 * fq;
#pragma unroll
        for (int ai = 0; ai < 2; ++ai)
#pragma unroll
            for (int m = 0; m < 4; ++m) { bf16_t* rowp = O + (size_t)(row0 + ai * HALF + m * 16) * ldc + col0;
#pragma unroll
                for (int bj = 0; bj < 2; ++bj) { const f32x4 v0 = acc[ai][bj][m][0], v1 = acc[ai][bj][m][1];
                    u32x4 w; w.x = cvt_pk_bf16(v0[0], v0[1]); w.y = cvt_pk_bf16(v0[2], v0[3]); w.z = cvt_pk_bf16(v1[0], v1[1]); w.w = cvt_pk_bf16(v1[2], v1[3]);
                    *(u32x4*)(rowp + bj * HALF) = w; } }
    }
};
template <int LOGN> struct GroupOrder {
    const PG8_LAS int* toff; int G, c;
    __device__ __forceinline__ bool next(int i, Unit& u) const {
        const int ntiles = __builtin_amdgcn_readfirstlane(toff[32]);
        const int L = i * G + c; if (L >= (ntiles << LOGN)) return false;
        const int pm = L >> LOGN, pl = L & ((1 << LOGN) - 1); const int e = __builtin_amdgcn_readfirstlane(toff[80 + pm]);
        u.pm = pm; u.pn = (e << LOGN) + pl; return true;
    }
    __device__ __forceinline__ void a_ready(const Unit&) const {}
    __device__ __forceinline__ void done(const Unit&) const {}
};
struct G1Order {
    int G, c; unsigned* cnt;
    __device__ __forceinline__ bool next(int i, Unit& u) const {
        const int L = i * G + c; if (L >= 1120) return false;
        if (L < 96) { u.pm = L / 3; u.pn = 32 + L % 3; return true; }
        int wgid = L - 96; { const int q = 1024 / NXCD, xcd = wgid % NXCD, off = wgid / NXCD; wgid = xcd * q + off; }
        const int nig = WGM * 32, gid = wgid / nig, fm = gid * WGM;
        u.pm = fm + ((wgid % nig) % WGM); u.pn = (wgid % nig) / WGM; return true;
    }
    __device__ __forceinline__ void a_ready(const Unit&) const {}
    __device__ __forceinline__ void done(const Unit& u) const {
        if (u.pn >= 32) { asm volatile("s_waitcnt vmcnt(0)" ::: "memory");
            if (__builtin_amdgcn_mbcnt_hi(~0u, __builtin_amdgcn_mbcnt_lo(~0u, 0u)) == 0u) __hip_atomic_fetch_add(cnt, 1u, __ATOMIC_RELAXED, __HIP_MEMORY_SCOPE_AGENT); }
    }
};
struct TriOrder {
    int pm, pn0, n;
    __device__ __forceinline__ bool next(int i, Unit& u) const { if (i >= n) return false; u.pm = pm; u.pn = pn0 + i; return true; }
    __device__ __forceinline__ void a_ready(const Unit&) const {}
    __device__ __forceinline__ void done(const Unit&) const {}
};
struct EpiBf16G1 {
    static constexpr bool PERM = true, AFTER_DRAIN = false;
    bf16_t* O; int ldc;
    __device__ __forceinline__ void operator()(const f32x4 (&acc)[2][2][4][2], const Unit& u, int wr, int wc, int fr, int fq) const {
        const int row0 = u.pm * BM + wr * 64 + fr, col0 = u.pn * BM + wc * 32 + 8 * fq;
        if (u.pn >= 32) {
#pragma unroll
            for (int ai = 0; ai < 2; ++ai)
#pragma unroll
                for (int m = 0; m < 4; ++m) { bf16_t* rowp = O + (size_t)(row0 + ai * HALF + m * 16) * ldc + col0;
#pragma unroll
                    for (int bj = 0; bj < 2; ++bj) { const f32x4 v0 = acc[ai][bj][m][0], v1 = acc[ai][bj][m][1];
                        u32x4 w; w.x = cvt_pk_bf16(v0[0], v0[1]); w.y = cvt_pk_bf16(v0[2], v0[3]); w.z = cvt_pk_bf16(v1[0], v1[1]); w.w = cvt_pk_bf16(v1[2], v1[3]);
                        asm volatile("global_store_dwordx4 %0, %1, off sc1\n\ts_nop 1" :: "v"(rowp + bj * HALF), "v"(w) : "memory"); } }
        } else {
#pragma unroll
            for (int ai = 0; ai < 2; ++ai)
#pragma unroll
                for (int m = 0; m < 4; ++m) { bf16_t* rowp = O + (size_t)(row0 + ai * HALF + m * 16) * ldc + col0;
#pragma unroll
                    for (int bj = 0; bj < 2; ++bj) { const f32x4 v0 = acc[ai][bj][m][0], v1 = acc[ai][bj][m][1];
                        u32x4 w; w.x = cvt_pk_bf16(v0[0], v0[1]); w.y = cvt_pk_bf16(v0[2], v0[3]); w.z = cvt_pk_bf16(v1[0], v1[1]); w.w = cvt_pk_bf16(v1[2], v1[3]);
                        *(u32x4*)(rowp + bj * HALF) = w; } }
        }
    }
};
template <bool RF32> struct EpiResB16 {
    static constexpr bool PERM = true, AFTER_DRAIN = false;
    bf16_t* C; const void* R; int ldc;
    __device__ __forceinline__ void operator()(const f32x4 (&acc)[2][2][4][2], const Unit& u, int wr, int wc, int fr, int fq) const {
        const int row0 = u.pm * BM + wr * 64 + fr, col0 = u.pn * BM + wc * 32 + 8 * fq;
#pragma unroll
        for (int ai = 0; ai < 2; ++ai) {
            f32x4 rf[4][2][2]; u32x4 rb[4][2];
#pragma unroll
            for (int m = 0; m < 4; ++m) { const size_t ro = (size_t)(row0 + ai * HALF + m * 16) * ldc + col0;
#pragma unroll
                for (int bj = 0; bj < 2; ++bj) {
                    if (RF32) { rf[m][bj][0] = *(const f32x4*)((const float*)R + ro + bj * HALF); rf[m][bj][1] = *(const f32x4*)((const float*)R + ro + bj * HALF + 4); }
                    else rb[m][bj] = *(const u32x4*)((const bf16_t*)R + ro + bj * HALF); } }
            asm volatile("s_waitcnt vmcnt(0)" ::: "memory");
#pragma unroll
            for (int m = 0; m < 4; ++m) { const size_t ro = (size_t)(row0 + ai * HALF + m * 16) * ldc + col0;
#pragma unroll
                for (int bj = 0; bj < 2; ++bj) { f32x4 v0 = acc[ai][bj][m][0], v1 = acc[ai][bj][m][1];
                    if (RF32) { v0 += rf[m][bj][0]; v1 += rf[m][bj][1]; }
                    else { const u32x4 r = rb[m][bj];
                        v0 += (f32x4){__builtin_bit_cast(float, r.x << 16), __builtin_bit_cast(float, r.x & 0xffff0000u), __builtin_bit_cast(float, r.y << 16), __builtin_bit_cast(float, r.y & 0xffff0000u)};
                        v1 += (f32x4){__builtin_bit_cast(float, r.z << 16), __builtin_bit_cast(float, r.z & 0xffff0000u), __builtin_bit_cast(float, r.w << 16), __builtin_bit_cast(float, r.w & 0xffff0000u)}; }
                    u32x4 w; w.x = cvt_pk_bf16(v0[0], v0[1]); w.y = cvt_pk_bf16(v0[2], v0[3]); w.z = cvt_pk_bf16(v1[0], v1[1]); w.w = cvt_pk_bf16(v1[2], v1[3]);
                    *(u32x4*)(C + ro + bj * HALF) = w; } } }
    }
};
template <class Epi, class Sched, bool ALIGN_EPI = false, bool SP2 = false>
__device__ __forceinline__ void gemm_phase(PG8_LAS unsigned char* lds, const Gemm g, const Sched& S, const Epi& E) {
    const int tid = otid(), wid = __builtin_amdgcn_readfirstlane(tid >> 6), lane = tid & 63, wr = wid >> 2, wc = wid & 3, fr = lane & 15, fq = lane >> 4;
    const int K = g.K, nt = K / BK;
    unsigned voffA[2], voffB[2];
#pragma unroll
    for (int i = 0; i < 2; ++i) { int R, C; stage_rc(tid * 16 + i * 8192, R, C); const int Rb = Epi::PERM ? ((R & ~31) + perm32(R & 31)) : R;
        voffA[i] = (unsigned)(R * K + C) * 2u; voffB[i] = (unsigned)(Rb * K + C) * 2u; }
    const size_t kstep = (size_t)(BK * 2);
    const size_t hstep = (size_t)HALF * K * 2;
    const size_t tstep = 2 * hstep;
    const unsigned ldsw = (unsigned)wid * 1024u;
    const int aoff = lds_byte(wr * 64 + fr, fq * 8), boff = lds_byte(wc * 32 + fr, fq * 8);
#define PG8_SA(b, h) (((b) * 2 + (h)) * HTB)
#define PG8_SB(b, h) ((4 + (b) * 2 + (h)) * HTB)
#define PG8_STAGE(bufoff, gbase, voff) do { _Pragma("unroll") for (int _i = 0; _i < 2; ++_i) \
        __builtin_amdgcn_global_load_lds((const unsigned*)((const char*)(gbase) + (voff)[_i]), (PG8_LAS unsigned*)(lds + (bufoff) + ldsw + _i * 8192), 16, 0, 0); } while (0)
#define PG8_LDA(dst, b, h) do { _Pragma("unroll") for (int m = 0; m < 4; ++m) _Pragma("unroll") for (int k = 0; k < 2; ++k) dst[m][k] = *(const PG8_LAS bf16x8*)(lds + PG8_SA(b, h) + aoff + m * 2048 + k * 1024); } while (0)
#define PG8_LDB(dst, b, h) do { _Pragma("unroll") for (int n = 0; n < 2; ++n) _Pragma("unroll") for (int k = 0; k < 2; ++k) dst[n][k] = *(const PG8_LAS bf16x8*)(lds + PG8_SB(b, h) + boff + n * 2048 + k * 1024); } while (0)
#define PG8_MMA(ai, bj, At, Bt) do { __builtin_amdgcn_s_setprio(1); _Pragma("unroll") for (int m = 0; m < 4; ++m) _Pragma("unroll") for (int n = 0; n < 2; ++n) _Pragma("unroll") for (int k = 0; k < 2; ++k) \
        acc[ai][bj][m][n] = __builtin_amdgcn_mfma_f32_16x16x32_bf16(Bt[n][k], At[m][k], acc[ai][bj][m][n], 0, 0, 0); __builtin_amdgcn_s_setprio(0); } while (0)
#define PG8_WAIT_V(n) asm volatile("s_waitcnt vmcnt(" #n ")" ::: "memory")
#define PG8_WAIT_L(n) asm volatile("s_waitcnt lgkmcnt(" #n ")" ::: "memory")
#define PG8_BAR __builtin_amdgcn_s_barrier()
#define PG8_SCHED __builtin_amdgcn_sched_barrier(0)
    Unit cur, nxt; int ui = 0;
    if (!S.next(0, cur)) return;
    f32x4 acc[2][2][4][2];
#pragma unroll
    for (int a = 0; a < 2; ++a)
#pragma unroll
        for (int b = 0; b < 2; ++b)
#pragma unroll
            for (int m = 0; m < 4; ++m)
#pragma unroll
                for (int n = 0; n < 2; ++n) acc[a][b][m][n] = (f32x4){0.f, 0.f, 0.f, 0.f};
    bf16x8 At[4][2], B0[2][2], B1[2][2];
    const char* cA = (const char*)g.A + (size_t)cur.pm * tstep; const char* cB = (const char*)g.Bt + (size_t)cur.pn * tstep;
    S.a_ready(cur);
    if constexpr (SP2) {
        PG8_STAGE(PG8_SB(0, 0), cB, voffB); PG8_STAGE(PG8_SB(0, 1), cB + hstep, voffB); PG8_STAGE(PG8_SA(0, 0), cA, voffA); PG8_STAGE(PG8_SA(0, 1), cA + hstep, voffA);
        if (wr == 1) PG8_BAR;
        PG8_WAIT_V(2); PG8_BAR;
        PG8_STAGE(PG8_SB(1, 0), cB + kstep, voffB); PG8_STAGE(PG8_SA(1, 0), cA + kstep, voffA); PG8_STAGE(PG8_SB(1, 1), cB + hstep + kstep, voffB);
        PG8_WAIT_V(6); PG8_BAR;
    } else {
        PG8_STAGE(PG8_SB(0, 0), cB, voffB); PG8_STAGE(PG8_SA(0, 0), cA, voffA); PG8_STAGE(PG8_SB(0, 1), cB + hstep, voffB); PG8_STAGE(PG8_SA(0, 1), cA + hstep, voffA);
        if (wr == 1) PG8_BAR;
        PG8_WAIT_V(4); PG8_BAR;
        PG8_STAGE(PG8_SB(1, 0), cB + kstep, voffB); PG8_STAGE(PG8_SA(1, 0), cA + kstep, voffA); PG8_STAGE(PG8_SB(1, 1), cB + hstep + kstep, voffB);
        PG8_WAIT_V(6); PG8_BAR;
    }
    for (;;) {
        const bool has_next = S.next(ui + 1, nxt);
        const char* nA = has_next ? (const char*)g.A + (size_t)nxt.pm * tstep : cA; const char* nB = has_next ? (const char*)g.Bt + (size_t)nxt.pn * tstep : cB;
        for (int t = 0; t < nt; t += 2) {
            const bool last = (t == nt - 2);
            const char* a1 = cA + (size_t)(t + 1) * kstep;
            const char* a2 = last ? nA : cA + (size_t)(t + 2) * kstep; const char* b2 = last ? nB : cB + (size_t)(t + 2) * kstep;
            const char* a3 = a2 + kstep; const char* b3 = b2 + kstep;
            if (last && has_next) S.a_ready(nxt);
            if constexpr (SP2) {
            PG8_LDB(B0, 0, 0); PG8_LDB(B1, 0, 1); PG8_SCHED; PG8_LDA(At, 0, 0); PG8_STAGE(PG8_SA(1, 1), a1 + hstep, voffA);
            PG8_WAIT_V(8); PG8_WAIT_L(0); PG8_BAR; PG8_MMA(0, 0, At, B0); PG8_MMA(0, 1, At, B1); PG8_BAR; PG8_SCHED;
            PG8_LDA(At, 0, 1); PG8_STAGE(PG8_SB(0, 0), b2, voffB); PG8_STAGE(PG8_SB(0, 1), b2 + hstep, voffB); PG8_STAGE(PG8_SA(0, 0), a2, voffA);
            PG8_WAIT_V(8); PG8_WAIT_L(0); PG8_BAR; PG8_MMA(1, 0, At, B0); PG8_MMA(1, 1, At, B1); PG8_BAR; PG8_SCHED;
            PG8_LDB(B0, 1, 0); PG8_LDB(B1, 1, 1); PG8_SCHED; PG8_LDA(At, 1, 0); PG8_STAGE(PG8_SA(0, 1), a2 + hstep, voffA);
            PG8_WAIT_V(8); PG8_WAIT_L(0); PG8_BAR; PG8_MMA(0, 0, At, B0); PG8_MMA(0, 1, At, B1); PG8_BAR; PG8_SCHED;
            PG8_LDA(At, 1, 1); PG8_STAGE(PG8_SB(1, 0), b3, voffB); PG8_STAGE(PG8_SB(1, 1), b3 + hstep, voffB); PG8_STAGE(PG8_SA(1, 0), a3, voffA);
            PG8_WAIT_V(8); PG8_WAIT_L(0); PG8_BAR; PG8_MMA(1, 0, At, B0); PG8_MMA(1, 1, At, B1); PG8_BAR; PG8_SCHED;
            } else {
            PG8_LDB(B0, 0, 0); PG8_SCHED; PG8_LDA(At, 0, 0); PG8_STAGE(PG8_SA(1, 1), a1 + hstep, voffA);
            PG8_WAIT_L(8); PG8_BAR; PG8_WAIT_L(0); PG8_MMA(0, 0, At, B0); PG8_BAR; PG8_SCHED;
            PG8_LDB(B1, 0, 1); PG8_STAGE(PG8_SB(0, 0), b2, voffB);
            PG8_BAR; PG8_WAIT_L(0); PG8_MMA(0, 1, At, B1); PG8_BAR;
            PG8_LDA(At, 0, 1); PG8_STAGE(PG8_SA(0, 0), a2, voffA);
            PG8_BAR; PG8_WAIT_L(0); PG8_MMA(1, 0, At, B0); PG8_BAR; PG8_SCHED;
            PG8_STAGE(PG8_SB(0, 1), b2 + hstep, voffB);
            PG8_WAIT_V(6); PG8_BAR; PG8_MMA(1, 1, At, B1); PG8_BAR;
            PG8_LDB(B0, 1, 0); PG8_SCHED; PG8_LDA(At, 1, 0); PG8_STAGE(PG8_SA(0, 1), a2 + hstep, voffA);
            PG8_WAIT_L(8); PG8_BAR; PG8_WAIT_L(0); PG8_MMA(0, 0, At, B0); PG8_BAR; PG8_SCHED;
            PG8_LDB(B1, 1, 1); PG8_STAGE(PG8_SB(1, 0), b3, voffB);
            PG8_BAR; PG8_WAIT_L(0); PG8_MMA(0, 1, At, B1); PG8_BAR;
            PG8_LDA(At, 1, 1); PG8_STAGE(PG8_SA(1, 0), a3, voffA);
            PG8_BAR; PG8_WAIT_L(0); PG8_MMA(1, 0, At, B0); PG8_BAR; PG8_SCHED;
            PG8_STAGE(PG8_SB(1, 1), b3 + hstep, voffB);
            PG8_WAIT_V(6); PG8_BAR; PG8_MMA(1, 1, At, B1); PG8_BAR;
            }
        }
        if constexpr (ALIGN_EPI) { if (wr == 0) PG8_BAR; }
        if constexpr (!Epi::AFTER_DRAIN) { E(acc, cur, wr, wc, fr, fq); S.done(cur); }
        if (!has_next) break;
#pragma unroll
        for (int a = 0; a < 2; ++a)
#pragma unroll
            for (int b = 0; b < 2; ++b)
#pragma unroll
                for (int m = 0; m < 4; ++m)
#pragma unroll
                    for (int n = 0; n < 2; ++n) acc[a][b][m][n] = (f32x4){0.f, 0.f, 0.f, 0.f};
        cur = nxt; cA = nA; cB = nB; ++ui;
        if constexpr (ALIGN_EPI) { if (wr == 1) PG8_BAR; }
    }
    PG8_WAIT_V(0);
    if constexpr (!ALIGN_EPI) { if (wr == 0) PG8_BAR; }
    PG8_BAR;
    if constexpr (Epi::AFTER_DRAIN) { E.fused(acc, cur, wr, wc, fr, fq, lds, wid, lane); S.done(cur); }
#undef PG8_SA
#undef PG8_SB
#undef PG8_STAGE
#undef PG8_LDA
#undef PG8_LDB
#undef PG8_MMA
#undef PG8_WAIT_V
#undef PG8_WAIT_L
#undef PG8_BAR
#undef PG8_SCHED
}
template <class Epi, class Sched, bool ALIGN_EPI = false, bool SP2 = false>
__device__ __forceinline__ void gemm_phase_ga(PG8_LAS unsigned char* lds, const Gemm g, const Sched& S, const Epi& E, const int* rowtok) {
    const int tid = otid(), wid = __builtin_amdgcn_readfirstlane(tid >> 6), lane = tid & 63, wr = wid >> 2, wc = wid & 3, fr = lane & 15, fq = lane >> 4;
    const int K = g.K, nt = K / BK;
    unsigned voffA[2], voffB[2];
#pragma unroll
    for (int i = 0; i < 2; ++i) { int R, C; stage_rc(tid * 16 + i * 8192, R, C); const int Rb = Epi::PERM ? ((R & ~31) + perm32(R & 31)) : R;
        voffA[i] = (unsigned)(R * K + C) * 2u; voffB[i] = (unsigned)(Rb * K + C) * 2u; }
    const size_t kstep = (size_t)(BK * 2);
    const size_t hstep = (size_t)HALF * K * 2;
    const size_t tstep = 2 * hstep;
    const unsigned ldsw = (unsigned)wid * 1024u;
    const int aoff = lds_byte(wr * 64 + fr, fq * 8), boff = lds_byte(wc * 32 + fr, fq * 8);
#define PG8_SA(b, h) (((b) * 2 + (h)) * HTB)
#define PG8_SB(b, h) ((4 + (b) * 2 + (h)) * HTB)
#define PG8_STAGE(bufoff, gbase, voff) do { _Pragma("unroll") for (int _i = 0; _i < 2; ++_i) \
        __builtin_amdgcn_global_load_lds((const unsigned*)((const char*)(gbase) + (voff)[_i]), (PG8_LAS unsigned*)(lds + (bufoff) + ldsw + _i * 8192), 16, 0, 0); } while (0)
#define PG8_LDA(dst, b, h) do { _Pragma("unroll") for (int m = 0; m < 4; ++m) _Pragma("unroll") for (int k = 0; k < 2; ++k) dst[m][k] = *(const PG8_LAS bf16x8*)(lds + PG8_SA(b, h) + aoff + m * 2048 + k * 1024); } while (0)
#define PG8_LDB(dst, b, h) do { _Pragma("unroll") for (int n = 0; n < 2; ++n) _Pragma("unroll") for (int k = 0; k < 2; ++k) dst[n][k] = *(const PG8_LAS bf16x8*)(lds + PG8_SB(b, h) + boff + n * 2048 + k * 1024); } while (0)
#define PG8_MMA(ai, bj, At, Bt) do { __builtin_amdgcn_s_setprio(1); _Pragma("unroll") for (int m = 0; m < 4; ++m) _Pragma("unroll") for (int n = 0; n < 2; ++n) _Pragma("unroll") for (int k = 0; k < 2; ++k) \
        acc[ai][bj][m][n] = __builtin_amdgcn_mfma_f32_16x16x32_bf16(Bt[n][k], At[m][k], acc[ai][bj][m][n], 0, 0, 0); __builtin_amdgcn_s_setprio(0); } while (0)
#define PG8_WAIT_V(n) asm volatile("s_waitcnt vmcnt(" #n ")" ::: "memory")
#define PG8_WAIT_L(n) asm volatile("s_waitcnt lgkmcnt(" #n ")" ::: "memory")
#define PG8_BAR __builtin_amdgcn_s_barrier()
#define PG8_SCHED __builtin_amdgcn_sched_barrier(0)
    Unit cur, nxt; int ui = 0;
    if (!S.next(0, cur)) return;
    f32x4 acc[2][2][4][2];
#pragma unroll
    for (int a = 0; a < 2; ++a)
#pragma unroll
        for (int b = 0; b < 2; ++b)
#pragma unroll
            for (int m = 0; m < 4; ++m)
#pragma unroll
                for (int n = 0; n < 2; ++n) acc[a][b][m][n] = (f32x4){0.f, 0.f, 0.f, 0.f};
    bf16x8 At[4][2], B0[2][2], B1[2][2];
    unsigned voffA0[2], voffA1[2];
#pragma unroll
    for (int i = 0; i < 2; ++i) { int R, C; stage_rc(tid * 16 + i * 8192, R, C); const int* rt = rowtok + cur.pm * BM;
        voffA0[i] = (unsigned)(rt[R] * K + C) * 2u; voffA1[i] = (unsigned)(rt[HALF + R] * K + C) * 2u; }
    const char* cA = (const char*)g.A; const char* cB = (const char*)g.Bt + (size_t)cur.pn * tstep;
    S.a_ready(cur);
    if constexpr (SP2) {
        PG8_STAGE(PG8_SB(0, 0), cB, voffB); PG8_STAGE(PG8_SB(0, 1), cB + hstep, voffB); PG8_STAGE(PG8_SA(0, 0), cA, voffA0); PG8_STAGE(PG8_SA(0, 1), cA, voffA1);
        if (wr == 1) PG8_BAR;
        PG8_WAIT_V(2); PG8_BAR;
        PG8_STAGE(PG8_SB(1, 0), cB + kstep, voffB); PG8_STAGE(PG8_SA(1, 0), cA + kstep, voffA0); PG8_STAGE(PG8_SB(1, 1), cB + hstep + kstep, voffB);
        PG8_WAIT_V(6); PG8_BAR;
    } else {
        PG8_STAGE(PG8_SB(0, 0), cB, voffB); PG8_STAGE(PG8_SA(0, 0), cA, voffA0); PG8_STAGE(PG8_SB(0, 1), cB + hstep, voffB); PG8_STAGE(PG8_SA(0, 1), cA, voffA1);
        if (wr == 1) PG8_BAR;
        PG8_WAIT_V(4); PG8_BAR;
        PG8_STAGE(PG8_SB(1, 0), cB + kstep, voffB); PG8_STAGE(PG8_SA(1, 0), cA + kstep, voffA0); PG8_STAGE(PG8_SB(1, 1), cB + hstep + kstep, voffB);
        PG8_WAIT_V(6); PG8_BAR;
    }
    for (;;) {
        const bool has_next = S.next(ui + 1, nxt);
        const char* nA = cA;     const char* nB = has_next ? (const char*)g.Bt + (size_t)nxt.pn * tstep : cB;
        for (int t = 0; t < nt; t += 2) {
            const bool last = (t == nt - 2);
            const char* a1 = cA + (size_t)(t + 1) * kstep;
            const char* a2 = last ? nA : cA + (size_t)(t + 2) * kstep; const char* b2 = last ? nB : cB + (size_t)(t + 2) * kstep;
            const char* a3 = a2 + kstep; const char* b3 = b2 + kstep;
            if (last && has_next) S.a_ready(nxt);
            if constexpr (SP2) {
            PG8_LDB(B0, 0, 0); PG8_LDB(B1, 0, 1); PG8_SCHED; PG8_LDA(At, 0, 0); PG8_STAGE(PG8_SA(1, 1), a1, voffA1);
            PG8_WAIT_V(8); PG8_WAIT_L(0); PG8_BAR; PG8_MMA(0, 0, At, B0); PG8_MMA(0, 1, At, B1); PG8_BAR; PG8_SCHED;
            PG8_LDA(At, 0, 1); PG8_STAGE(PG8_SB(0, 0), b2, voffB); PG8_STAGE(PG8_SB(0, 1), b2 + hstep, voffB); PG8_STAGE(PG8_SA(0, 0), a2, voffA0);
            PG8_WAIT_V(8); PG8_WAIT_L(0); PG8_BAR; PG8_MMA(1, 0, At, B0); PG8_MMA(1, 1, At, B1); PG8_BAR; PG8_SCHED;
            PG8_LDB(B0, 1, 0); PG8_LDB(B1, 1, 1); PG8_SCHED; PG8_LDA(At, 1, 0); PG8_STAGE(PG8_SA(0, 1), a2, voffA1);
            PG8_WAIT_V(8); PG8_WAIT_L(0); PG8_BAR; PG8_MMA(0, 0, At, B0); PG8_MMA(0, 1, At, B1); PG8_BAR; PG8_SCHED;
            PG8_LDA(At, 1, 1); PG8_STAGE(PG8_SB(1, 0), b3, voffB); PG8_STAGE(PG8_SB(1, 1), b3 + hstep, voffB); PG8_STAGE(PG8_SA(1, 0), a3, voffA0);
            PG8_WAIT_V(8); PG8_WAIT_L(0); PG8_BAR; PG8_MMA(1, 0, At, B0); PG8_MMA(1, 1, At, B1); PG8_BAR; PG8_SCHED;
            } else {
            PG8_LDB(B0, 0, 0); PG8_SCHED; PG8_LDA(At, 0, 0); PG8_STAGE(PG8_SA(1, 1), a1, voffA1);
            PG8_WAIT_L(8); PG8_BAR; PG8_WAIT_L(0); PG8_MMA(0, 0, At, B0); PG8_BAR; PG8_SCHED;
            PG8_LDB(B1, 0, 1); PG8_STAGE(PG8_SB(0, 0), b2, voffB);
            PG8_BAR; PG8_WAIT_L(0); PG8_MMA(0, 1, At, B1); PG8_BAR;
            PG8_LDA(At, 0, 1); PG8_STAGE(PG8_SA(0, 0), a2, voffA0);
            PG8_BAR; PG8_WAIT_L(0); PG8_MMA(1, 0, At, B0); PG8_BAR; PG8_SCHED;
            PG8_STAGE(PG8_SB(0, 1), b2 + hstep, voffB);
            PG8_WAIT_V(6); PG8_BAR; PG8_MMA(1, 1, At, B1); PG8_BAR;
            PG8_LDB(B0, 1, 0); PG8_SCHED; PG8_LDA(At, 1, 0); PG8_STAGE(PG8_SA(0, 1), a2, voffA1);
            PG8_WAIT_L(8); PG8_BAR; PG8_WAIT_L(0); PG8_MMA(0, 0, At, B0); PG8_BAR; PG8_SCHED;
            PG8_LDB(B1, 1, 1); PG8_STAGE(PG8_SB(1, 0), b3, voffB);
            PG8_BAR; PG8_WAIT_L(0); PG8_MMA(0, 1, At, B1); PG8_BAR;
            PG8_LDA(At, 1, 1); PG8_STAGE(PG8_SA(1, 0), a3, voffA0);
            PG8_BAR; PG8_WAIT_L(0); PG8_MMA(1, 0, At, B0); PG8_BAR; PG8_SCHED;
            PG8_STAGE(PG8_SB(1, 1), b3 + hstep, voffB);
            PG8_WAIT_V(6); PG8_BAR; PG8_MMA(1, 1, At, B1); PG8_BAR;
            }
        }
        if constexpr (ALIGN_EPI) { if (wr == 0) PG8_BAR; }
        if constexpr (!Epi::AFTER_DRAIN) { E(acc, cur, wr, wc, fr, fq); S.done(cur); }
        if (!has_next) break;
#pragma unroll
        for (int a = 0; a < 2; ++a)
#pragma unroll
            for (int b = 0; b < 2; ++b)
#pragma unroll
                for (int m = 0; m < 4; ++m)
#pragma unroll
                    for (int n = 0; n < 2; ++n) acc[a][b][m][n] = (f32x4){0.f, 0.f, 0.f, 0.f};
        cur = nxt; cA = nA; cB = nB; ++ui;
        if constexpr (ALIGN_EPI) { if (wr == 1) PG8_BAR; }
    }
    PG8_WAIT_V(0);
    if constexpr (!ALIGN_EPI) { if (wr == 0) PG8_BAR; }
    PG8_BAR;
    if constexpr (Epi::AFTER_DRAIN) { E.fused(acc, cur, wr, wc, fr, fq, lds, wid, lane); S.done(cur); }
#undef PG8_SA
#undef PG8_SB
#undef PG8_STAGE
#undef PG8_LDA
#undef PG8_LDB
#undef PG8_MMA
#undef PG8_WAIT_V
#undef PG8_WAIT_L
#undef PG8_BAR
#undef PG8_SCHED
}
}

#ifndef PG8_SP2
#define PG8_SP2 false
#endif
#define GAS __attribute__((address_space(1)))
#define LAS __attribute__((address_space(3)))
typedef unsigned short bf16;
typedef unsigned v4u __attribute__((ext_vector_type(4)));
typedef unsigned v2u __attribute__((ext_vector_type(2)));
typedef float f32x4 __attribute__((ext_vector_type(4)));
#define LDS_WAIT() asm volatile("s_waitcnt lgkmcnt(0)" ::: "memory")

#ifndef MK_SPLIT
#define MK_SPLIT 0
#endif

constexpr int NTOK = 8192, SEQ = 2048, DM = 2048, NIN = 8204, NP = 8960;
constexpr int C_RR = 0, C_RK = 768, C_RV = 1536, C_RG = 2304, C_TQ = 3072, C_TK = 3584, C_TV = 4096, C_TG = 4608, C_DQ = 5120, C_DZ = 7424, C_DA = 8192, C_DB = 8198;
constexpr int C_P1W = 8208, C_P2W = 8304, C_P1A = 8400, C_P2A = 8496, C_P1V = 8592, C_P2V = 8656, C_END = 8720;
constexpr int NLR = 2304, NOR = 1280, MAXROWS = 24576;
constexpr int NWAVES = 8, NTHR = 512;

constexpr size_t MiB = 1u << 20;
constexpr size_t WS_CTL = 0, CTL_BYTES = 1 * MiB;
constexpr size_t WS_WIN = WS_CTL + CTL_BYTES;
constexpr size_t WS_WOUT = WS_WIN + (size_t)NP * DM * 2;
constexpr size_t WS_W13 = WS_WOUT + (size_t)DM * DM * 2;
constexpr size_t WS_W2 = WS_W13 + (size_t)32 * 512 * DM * 2;
constexpr size_t WS_LR2 = WS_W2 + (size_t)32 * DM * 256 * 2;
constexpr size_t WS_RW = WS_LR2 + (size_t)NLR * 256 * 2;
constexpr size_t WS_H = WS_RW + (size_t)DM * 48 * 4;
constexpr size_t WS_MIX = WS_H + (size_t)NTOK * DM * 2;
constexpr size_t WS_XBUF = WS_MIX + (size_t)NTOK * DM * 2;
constexpr size_t WS_BIG = WS_XBUF + (size_t)NTOK * DM * 4;
constexpr size_t WS_PROJ = WS_BIG;
constexpr size_t WS_LR = WS_PROJ + (size_t)NTOK * NP * 2;
constexpr size_t WS_ORAW = WS_LR + (size_t)NTOK * NLR * 2;
constexpr size_t BIG_A = (size_t)NTOK * NP * 2 + (size_t)NTOK * NLR * 2 + (size_t)NTOK * NOR * 4;
constexpr size_t WS_SA = WS_BIG;
constexpr size_t WS_YS = WS_SA + (size_t)MAXROWS * DM * 2;
constexpr size_t BIG_B = (size_t)2 * MAXROWS * DM * 2;
constexpr size_t WS_HID = WS_BIG + (BIG_A > BIG_B ? BIG_A : BIG_B);
constexpr size_t WS_A2 = WS_HID + (size_t)MAXROWS * 256 * 2;
constexpr size_t WS_VF = WS_A2 + (size_t)NTOK * 256 * 2;
constexpr size_t WS_ROUTE = WS_VF + (size_t)NTOK * 768 * 4;
constexpr size_t WS_GATE = WS_ROUTE + (size_t)NTOK * 16;
constexpr size_t WS_POS = WS_GATE + (size_t)NTOK * 8;
constexpr size_t WS_BLOBG = WS_POS + (size_t)NTOK * 8;
constexpr size_t WS_PCS = WS_BLOBG + (size_t)768 * 106496;
constexpr size_t WS_BON = WS_PCS + (size_t)(1536 * 64 + 768 * 128 + 512 * 128) * 4;
constexpr size_t WS_ROWTOK = WS_BON + (size_t)NTOK * 12 * 4;
constexpr size_t WS_END = WS_ROWTOK + (size_t)MAXROWS * 4;
constexpr size_t WS_W2X = WS_XBUF + (size_t)NTOK * DM * 2;
constexpr size_t WS_BLOBW = WS_W13;
constexpr size_t WS_BLOBR = WS_H;
static_assert((size_t)1536 * 65536 <= (size_t)32 * 512 * DM * 2 + (size_t)32 * DM * 256 * 2 && (size_t)512 * 57344 <= (size_t)NTOK * DM * 2 && WS_END <= 643000000, "workspace map");
constexpr int CW_BAR = 1024;
constexpr int CW_P1 = 64;
constexpr int CW_CNT = 8192;

constexpr int RING_BYTES = 131072, MISC_OFF = 146432, LDS_BYTES = 163840;
static_assert(TIDTAB_OFF >= MISC_OFF + 1024 && TIDTAB_OFF + 16384 <= LDS_BYTES, "LDS map");

__device__ __forceinline__ float bf2f(bf16 v) { return __builtin_bit_cast(float, (unsigned)v << 16); }
__device__ __forceinline__ unsigned f2bf(float f) { unsigned u = __builtin_bit_cast(unsigned, f); return (u + 0x7fffu + ((u >> 16) & 1u)) >> 16; }
__device__ __forceinline__ unsigned pk2(float lo, float hi) { return f2bf(lo) | (f2bf(hi) << 16); }
typedef __bf16 hb2_t __attribute__((ext_vector_type(2)));
typedef float hf2_t __attribute__((ext_vector_type(2)));
__device__ __forceinline__ unsigned pk2h(float lo, float hi) { const hf2_t v = {lo, hi}; const hb2_t b = __builtin_convertvector(v, hb2_t); return __builtin_bit_cast(unsigned, b); }
__device__ __forceinline__ unsigned f2bfh(float f) { return pk2h(f, f) & 0xffffu; }
__device__ __forceinline__ void unpk4(v2u p, float (&f)[4]) { f[0] = __builtin_bit_cast(float, p.x << 16); f[1] = __builtin_bit_cast(float, p.x & 0xffff0000u); f[2] = __builtin_bit_cast(float, p.y << 16); f[3] = __builtin_bit_cast(float, p.y & 0xffff0000u); }
__device__ __forceinline__ void unpk8(v4u p, float (&f)[8]) { f[0] = __builtin_bit_cast(float, p.x << 16); f[1] = __builtin_bit_cast(float, p.x & 0xffff0000u); f[2] = __builtin_bit_cast(float, p.y << 16); f[3] = __builtin_bit_cast(float, p.y & 0xffff0000u);
    f[4] = __builtin_bit_cast(float, p.z << 16); f[5] = __builtin_bit_cast(float, p.z & 0xffff0000u); f[6] = __builtin_bit_cast(float, p.w << 16); f[7] = __builtin_bit_cast(float, p.w & 0xffff0000u); }
__device__ __forceinline__ float sigmoidf_(float x) { return __builtin_amdgcn_rcpf(1.0f + __expf(-x)); }
__device__ __forceinline__ float siluf_(float x) { return x * __builtin_amdgcn_rcpf(1.0f + __expf(-x)); }
template <int CTRL> __device__ __forceinline__ float dppf(float x) { return __builtin_bit_cast(float, __builtin_amdgcn_mov_dpp(__builtin_bit_cast(int, x), CTRL, 0xf, 0xf, true)); }
__device__ __forceinline__ float red8(float v) { v += dppf<0xB1>(v); v += dppf<0x4E>(v); v += dppf<0x141>(v); return v; }
__device__ __forceinline__ float red16(float v) { v = red8(v); v += dppf<0x128>(v); return v; }
__device__ __forceinline__ float wave_sum(float v) {
    v = red16(v);
    v += __builtin_bit_cast(float, __builtin_amdgcn_update_dpp(0, __builtin_bit_cast(int, v), 0x142, 0xa, 0xf, false));
    v += __builtin_bit_cast(float, __builtin_amdgcn_update_dpp(0, __builtin_bit_cast(int, v), 0x143, 0xc, 0xf, false));
    return __builtin_bit_cast(float, __builtin_amdgcn_readlane(__builtin_bit_cast(int, v), 63));
}

struct Args { const void* in[36]; float* out; unsigned char* ws; int ph_lo, ph_hi; };

enum { I_X = 0, I_POS, I_N1W, I_WIN, I_WOUT, I_MU_RKVG, I_MU_WA, I_W0, I_W1, I_W2, I_A0, I_A1, I_A2, I_KK, I_KA, I_RK, I_LNW, I_LNB, I_MU_V, I_V0, I_V1, I_V2,
       I_RET_GN, I_CONVW, I_ALOG, I_DTB, I_GDN_NW, I_N2W, I_MGW, I_MGB, I_MEW, I_MEB, I_MW1, I_MW3, I_MW2, I_FNW };

typedef const Args __attribute__((address_space(4)))* CArgs;
#define INF(i) ((const float*)Ap->in[i])

__device__ __forceinline__ void tr_item(const float* W, int ldn, int nsrc, int ndst, const float* sc, int scmode, bf16* __restrict__ WT, int Kd, int k0, int n0, size_t drow0, LAS float* scr, int lane) {
    const int col = lane & 31;
    const bool okc = (n0 + col < nsrc); const int cc = okc ? (n0 + col) : 0; const float mkc = okc ? 1.f : 0.f;
    const float* Wc = (nsrc > 0) ? W : sc;
    const float* wp = Wc + ((nsrc > 0) ? ((size_t)(k0 + (lane >> 5)) * ldn + cc) : 0); const size_t wstep = (nsrc > 0) ? (size_t)2 * ldn : 0;
#pragma unroll
    for (int i = 0; i < 32; ++i) { const int kk = 2 * i + (lane >> 5); float v = __builtin_nontemporal_load(wp + i * wstep) * mkc;
        if (scmode) { const float s = sc[k0 + kk]; v *= (scmode == 1 ? 1.0f - s : s); }
        scr[kk * 33 + col] = v; }
    LDS_WAIT(); asm volatile("" ::: "memory");
    const int c = lane & 7;
#pragma unroll
    for (int j = 0; j < 4; ++j) { const int n = (lane >> 3) + 8 * j; const LAS float* s = scr + (8 * c) * 33 + n;
        v4u o; o.x = pk2(s[0 * 33], s[1 * 33]); o.y = pk2(s[2 * 33], s[3 * 33]); o.z = pk2(s[4 * 33], s[5 * 33]); o.w = pk2(s[6 * 33], s[7 * 33]);
        if (n0 + n < ndst) *(v4u*)(WT + (drow0 + n) * (size_t)Kd + k0 + 8 * c) = o; }
    LDS_WAIT(); asm volatile("" ::: "memory");
}

template <int PART  > __device__ __forceinline__ void phase_convert(CArgs Ap, int l, LAS unsigned char* lds, int bidx, int nblk, int r0 = 0, int r1 = 1 << 30) {
    const int tid = otid(), lane = tid & 63, wave = __builtin_amdgcn_readfirstlane(tid >> 6);
    LAS float* scr = (LAS float*)(lds + wave * 8704);
    const int gw = bidx * NWAVES + wave, NGW = nblk * NWAVES;
    unsigned char* ws = Ap->ws;
    bf16* WinT = (bf16*)(ws + WS_WIN); bf16* WoutT = (bf16*)(ws + WS_WOUT); bf16* W13T = (bf16*)(ws + WS_W13); bf16* W2T = (bf16*)(ws + WS_W2X);
    constexpr int I_IN = 32 * 257, I_EX = 32 * 16, I_OUT = 32 * 64, I_M13 = 32 * 2 * 32 * 8, I_M2 = 32 * 4 * 64;
    constexpr int NITEMS = I_IN + I_EX + I_OUT + I_M13 + I_M2;
    constexpr int IT_LO = (PART == 0) ? 0 : (PART == 1) ? I_IN + I_EX + I_OUT : I_IN + I_EX + I_OUT + I_M13, IT_HI = (PART == 0) ? I_IN + I_EX + I_OUT : (PART == 1) ? I_IN + I_EX + I_OUT + I_M13 : NITEMS;
    const int it_hi = (r1 < IT_HI - IT_LO) ? IT_LO + r1 : IT_HI;
    for (int it = IT_LO + r0 + gw; it < it_hi; it += NGW) {
        int r = it;
        if (r < I_IN) { const int kb = r / 257, nb = r % 257;
            tr_item(INF(I_WIN) + (size_t)l * DM * NIN, NIN, NIN, 8208, nullptr, 0, WinT, DM, 64 * kb, 32 * nb, (size_t)32 * nb, scr, lane); continue; }
        r -= I_IN;
        if (r < I_EX) { const int kb = r / 16, sub = r % 16;
            const float* W; const float* sc; int mode, nloc, ldn, nsrc; size_t drow;
            if (sub < 3)       { W = INF(I_W1) + (size_t)l * DM * 96; sc = INF(I_MU_WA) + (size_t)(l * 2 + 0) * DM; mode = 1; nloc = sub;      ldn = 96; nsrc = 96; drow = C_P1W; }
            else if (sub < 6)  { W = INF(I_W1) + (size_t)l * DM * 96; sc = INF(I_MU_WA) + (size_t)(l * 2 + 0) * DM; mode = 2; nloc = sub - 3;  ldn = 96; nsrc = 96; drow = C_P2W; }
            else if (sub < 9)  { W = INF(I_A1) + (size_t)l * DM * 96; sc = INF(I_MU_WA) + (size_t)(l * 2 + 1) * DM; mode = 1; nloc = sub - 6;  ldn = 96; nsrc = 96; drow = C_P1A; }
            else if (sub < 12) { W = INF(I_A1) + (size_t)l * DM * 96; sc = INF(I_MU_WA) + (size_t)(l * 2 + 1) * DM; mode = 2; nloc = sub - 9;  ldn = 96; nsrc = 96; drow = C_P2A; }
            else if (sub < 14) { W = INF(I_V1); sc = INF(I_MU_V); mode = 1; nloc = sub - 12; ldn = 64; nsrc = (l > 0) ? 64 : 0; drow = C_P1V; }
            else               { W = INF(I_V1); sc = INF(I_MU_V); mode = 2; nloc = sub - 14; ldn = 64; nsrc = (l > 0) ? 64 : 0; drow = C_P2V; }
            tr_item(W, ldn, nsrc, 1 << 30, sc, mode, WinT, DM, 64 * kb, 32 * nloc, drow + 32 * nloc, scr, lane); continue; }
        r -= I_EX;
        if (r < I_OUT) { const int kb = r / 64, nb = r % 64;
            tr_item(INF(I_WOUT) + (size_t)l * DM * DM, DM, DM, 1 << 30, nullptr, 0, WoutT, DM, 64 * kb, 32 * nb, (size_t)32 * nb, scr, lane); continue; }
        r -= I_OUT;
        if (r < I_M13) { const int e = r / 512, r1 = r % 512, mat = r1 / 256, r2 = r1 % 256, kb = r2 / 8, nb = r2 % 8;
            const float* W = INF(mat ? I_MW3 : I_MW1) + (size_t)(l * 32 + e) * DM * 256;
            const int f0 = 32 * nb, pn = f0 / 128, j0 = f0 % 128;
            tr_item(W, 256, 256, 1 << 30, nullptr, 0, W13T, DM, 64 * kb, f0, (size_t)e * 512 + pn * 256 + mat * 128 + j0, scr, lane); continue; }
        r -= I_M13;
        { const int e = r / 256, r1 = r % 256, kb = r1 / 64, nb = r1 % 64;
            tr_item(INF(I_MW2) + (size_t)(l * 32 + e) * 256 * DM, DM, DM, 1 << 30, nullptr, 0, W2T, 256, 64 * kb, 32 * nb, (size_t)e * DM + 32 * nb, scr, lane); }
    }
    if (PART != 0) return;
    const size_t gt = (size_t)bidx * NTHR + tid, NGT = (size_t)nblk * NTHR;
    { v4u* z = (v4u*)(WinT + (size_t)C_END * DM); const size_t n16 = (size_t)(NP - C_END) * DM / 8; const v4u zero = {0u, 0u, 0u, 0u};
        for (size_t i = gt; i < n16; i += NGT) z[i] = zero; }
    { bf16* LR2T = (bf16*)(ws + WS_LR2);
        const float* w2 = INF(I_W2) + (size_t)l * 96 * 768; const float* a2 = INF(I_A2) + (size_t)l * 96 * 768; const float* v2 = INF(I_V2);
        for (size_t i = gt; i < (size_t)NLR * 256; i += NGT) { const int n = (int)(i >> 8), k = (int)(i & 255); float v = 0.f;
            if (n < 768) { if (k < 96) v = w2[(size_t)k * 768 + n]; }
            else if (n < 1536) { if (k >= 96 && k < 192) v = a2[(size_t)(k - 96) * 768 + (n - 768)]; }
            else { if (k >= 192 && l > 0) v = v2[(size_t)(k - 192) * 768 + (n - 1536)]; }
            LR2T[i] = (bf16)f2bf(v); } }
    { float* RW = (float*)(ws + WS_RW); const float* nw = INF(I_N2W) + (size_t)l * DM; const float* gwp = INF(I_MGW) + (size_t)l * DM * 4; const float* ewp = INF(I_MEW) + (size_t)l * DM * 32;
        for (size_t i = gt; i < (size_t)DM * 48; i += NGT) { const int n = (int)(i / DM), k = (int)(i % DM); float v = 0.f;
            if (n < 4) v = gwp[k * 4 + n]; else if (n < 36) v = ewp[k * 32 + (n - 4)];
            RW[i] = v * nw[k]; } }
}

__device__ __forceinline__ void phase_norm(CArgs Ap, int mode, int l) {
    const int tid = otid(), lane = tid & 63, wave = __builtin_amdgcn_readfirstlane(tid >> 6);
    const int gw = blockIdx.x * NWAVES + wave, NGW = gridDim.x * NWAVES;
    unsigned char* ws = Ap->ws;
    bf16* XBUF = (bf16*)(ws + WS_XBUF); bf16* __restrict__ H = (bf16*)(ws + WS_H); float* __restrict__ OUTF = Ap->out;
    const bf16* YS = (const bf16*)(ws + WS_YS); const int* POS = (const int*)(ws + WS_POS); const float* GATE = (const float*)(ws + WS_GATE);
    const float* nw = (mode == 2) ? INF(I_FNW) : INF(I_N1W) + (size_t)l * DM;
#pragma unroll 2
    for (int m = gw; m < NTOK; m += NGW) {
        float v[4][8];
        if (mode == 0) { const float* src = INF(I_X) + (size_t)m * DM;
#pragma unroll
            for (int j = 0; j < 4; ++j) { const f32x4 a = *((const f32x4*)src + 2 * (lane + 64 * j)), b = *((const f32x4*)src + 2 * (lane + 64 * j) + 1);
                v[j][0] = a.x; v[j][1] = a.y; v[j][2] = a.z; v[j][3] = a.w; v[j][4] = b.x; v[j][5] = b.y; v[j][6] = b.z; v[j][7] = b.w; }
        } else {
            const int p0 = POS[2 * m], p1 = POS[2 * m + 1]; const float g0 = GATE[2 * m], g1 = GATE[2 * m + 1];
            v4u xv[4], ya[4], yb[4];
#pragma unroll
            for (int j = 0; j < 4; ++j) { xv[j] = *((const v4u*)(XBUF + (size_t)m * DM) + lane + 64 * j); ya[j] = *((const v4u*)(YS + (size_t)p0 * DM) + lane + 64 * j); yb[j] = *((const v4u*)(YS + (size_t)p1 * DM) + lane + 64 * j); }
#pragma unroll
            for (int j = 0; j < 4; ++j) { float fa[8], fb[8]; unpk8(xv[j], v[j]); unpk8(ya[j], fa); unpk8(yb[j], fb);
#pragma unroll
                for (int e = 0; e < 8; ++e) v[j][e] += g0 * fa[e] + g1 * fb[e]; }
            if (mode == 1) {
#pragma unroll
                for (int j = 0; j < 4; ++j) { v4u o; o.x = pk2(v[j][0], v[j][1]); o.y = pk2(v[j][2], v[j][3]); o.z = pk2(v[j][4], v[j][5]); o.w = pk2(v[j][6], v[j][7]);
                    *((v4u*)(XBUF + (size_t)m * DM) + lane + 64 * j) = o; } }
        }
        float ss = 0.f;
#pragma unroll
        for (int j = 0; j < 4; ++j) ss += ((v[j][0] * v[j][0] + v[j][1] * v[j][1]) + (v[j][2] * v[j][2] + v[j][3] * v[j][3])) + ((v[j][4] * v[j][4] + v[j][5] * v[j][5]) + (v[j][6] * v[j][6] + v[j][7] * v[j][7]));
        const float rstd = rsqrtf(wave_sum(ss) * (1.0f / DM) + 1e-6f);
#pragma unroll
        for (int j = 0; j < 4; ++j) { const f32x4 w0 = *((const f32x4*)nw + 2 * (lane + 64 * j)), w1 = *((const f32x4*)nw + 2 * (lane + 64 * j) + 1);
            const f32x4 y0 = (f32x4){v[j][0], v[j][1], v[j][2], v[j][3]} * rstd * w0, y1 = (f32x4){v[j][4], v[j][5], v[j][6], v[j][7]} * rstd * w1;
            if (mode == 2) { *((f32x4*)(OUTF + (size_t)m * DM) + 2 * (lane + 64 * j)) = y0; *((f32x4*)(OUTF + (size_t)m * DM) + 2 * (lane + 64 * j) + 1) = y1; }
            else { v4u o; o.x = pk2(y0.x, y0.y); o.y = pk2(y0.z, y0.w); o.z = pk2(y1.x, y1.y); o.w = pk2(y1.z, y1.w); *((v4u*)(H + (size_t)m * DM) + lane + 64 * j) = o; } }
    }
}

__device__ __forceinline__ void phase_e1(CArgs Ap, int l) {
    const bf16* PROJ = (const bf16*)(Ap->ws + WS_PROJ); bf16* __restrict__ A2 = (bf16*)(Ap->ws + WS_A2);
    const size_t gt = (size_t)blockIdx.x * NTHR + otid(), NGT = (size_t)gridDim.x * NTHR;
    for (size_t i = gt; i < (size_t)NTOK * 256; i += NGT) { const int m = (int)(i >> 8), j = (int)(i & 255); const bool hp = (m % SEQ) > 0;
        int c1, c2, jj; if (j < 96) { c1 = C_P1W; c2 = C_P2W; jj = j; } else if (j < 192) { c1 = C_P1A; c2 = C_P2A; jj = j - 96; } else { c1 = C_P1V; c2 = C_P2V; jj = j - 192; }
        float v = bf2f(PROJ[(size_t)m * NP + c1 + jj]) + (hp ? 1.f : 0.f) * bf2f(PROJ[(size_t)(hp ? m - 1 : m) * NP + c2 + jj]);
        if (j < 96) v = 1.0f - 2.0f * __builtin_amdgcn_rcpf(1.0f + __expf(2.0f * v));
        if (j >= 192 && l == 0) v = 0.f;
        A2[i] = (bf16)f2bf(v); }
}

__device__ __forceinline__ void phase_r1(CArgs Ap, int l, LAS unsigned char* lds) {
    const int tid = otid(), lane = tid & 63, wave = __builtin_amdgcn_readfirstlane(tid >> 6);
    const bf16* XBUF = (const bf16*)(Ap->ws + WS_XBUF); bf16* __restrict__ XN = (bf16*)(Ap->ws + WS_H); const float* RW = (const float*)(Ap->ws + WS_RW);
    unsigned* CNT = (unsigned*)(Ap->ws + WS_CTL) + CW_CNT + 8192 * l; int* ROUTE = (int*)(Ap->ws + WS_ROUTE); float* GATE = (float*)(Ap->ws + WS_GATE);
    const float* nw = INF(I_N2W) + (size_t)l * DM;
    LAS float* RSTD = (LAS float*)lds;
    LAS float* LOG = RSTD + 32;
    LAS float* LPART = LOG + 32 * 48;
    for (int tb = blockIdx.x; tb < NTOK / 32; tb += gridDim.x) { const int m0 = tb * 32;
#pragma unroll 1
        for (int j = 0; j < 4; ++j) { const int r = wave * 4 + j; const size_t m = (size_t)m0 + r;
            float v[4][8]; float ss = 0.f; v4u xv[4];
#pragma unroll
            for (int jj = 0; jj < 4; ++jj) xv[jj] = *((const v4u*)(XBUF + m * DM) + lane + 64 * jj);
#pragma unroll
            for (int jj = 0; jj < 4; ++jj) { unpk8(xv[jj], v[jj]);
                ss += ((v[jj][0] * v[jj][0] + v[jj][1] * v[jj][1]) + (v[jj][2] * v[jj][2] + v[jj][3] * v[jj][3])) + ((v[jj][4] * v[jj][4] + v[jj][5] * v[jj][5]) + (v[jj][6] * v[jj][6] + v[jj][7] * v[jj][7])); }
            const float rstd = rsqrtf(wave_sum(ss) * (1.0f / DM) + 1e-6f);
            if (lane == 0) RSTD[r] = rstd;
#pragma unroll
            for (int jj = 0; jj < 4; ++jj) { const f32x4 w0 = *((const f32x4*)nw + 2 * (lane + 64 * jj)), w1 = *((const f32x4*)nw + 2 * (lane + 64 * jj) + 1);
                const f32x4 y0 = (f32x4){v[jj][0], v[jj][1], v[jj][2], v[jj][3]} * rstd * w0, y1 = (f32x4){v[jj][4], v[jj][5], v[jj][6], v[jj][7]} * rstd * w1;
                v4u o; o.x = pk2(y0.x, y0.y); o.y = pk2(y0.z, y0.w); o.z = pk2(y1.x, y1.y); o.w = pk2(y1.z, y1.w); *((v4u*)(XN + m * DM) + lane + 64 * jj) = o; } }
        { const int fr = lane & 15, fq = lane >> 4;
            const bf16* xa = XBUF + (size_t)(m0 + fr) * DM + 256 * wave + 8 * fq; const float* wb = RW + (size_t)fr * DM + 256 * wave + 8 * fq;
            f32x4 acc[2][3];
#pragma unroll
            for (int a = 0; a < 2; ++a)
#pragma unroll
                for (int b = 0; b < 3; ++b) acc[a][b] = (f32x4){0.f, 0.f, 0.f, 0.f};
#pragma unroll 2
            for (int s = 0; s < 8; ++s) {
                float a0[8], a1[8]; unpk8(*(const v4u*)(xa + 32 * s), a0); unpk8(*(const v4u*)(xa + 16 * DM + 32 * s), a1);
                const f32x4 b0l = *(const f32x4*)(wb + 32 * s), b0h = *(const f32x4*)(wb + 32 * s + 4), b1l = *(const f32x4*)(wb + 16 * DM + 32 * s), b1h = *(const f32x4*)(wb + 16 * DM + 32 * s + 4),
                            b2l = *(const f32x4*)(wb + 32 * DM + 32 * s), b2h = *(const f32x4*)(wb + 32 * DM + 32 * s + 4);
#pragma unroll
                for (int i = 0; i < 8; ++i) { const float e0 = (i < 4) ? b0l[i & 3] : b0h[i & 3], e1 = (i < 4) ? b1l[i & 3] : b1h[i & 3], e2 = (i < 4) ? b2l[i & 3] : b2h[i & 3];
                    acc[0][0] = __builtin_amdgcn_mfma_f32_16x16x4f32(a0[i], e0, acc[0][0], 0, 0, 0); acc[0][1] = __builtin_amdgcn_mfma_f32_16x16x4f32(a0[i], e1, acc[0][1], 0, 0, 0);
                    acc[0][2] = __builtin_amdgcn_mfma_f32_16x16x4f32(a0[i], e2, acc[0][2], 0, 0, 0); acc[1][0] = __builtin_amdgcn_mfma_f32_16x16x4f32(a1[i], e0, acc[1][0], 0, 0, 0);
                    acc[1][1] = __builtin_amdgcn_mfma_f32_16x16x4f32(a1[i], e1, acc[1][1], 0, 0, 0); acc[1][2] = __builtin_amdgcn_mfma_f32_16x16x4f32(a1[i], e2, acc[1][2], 0, 0, 0); } }
#pragma unroll
            for (int a = 0; a < 2; ++a)
#pragma unroll
                for (int b = 0; b < 3; ++b)
#pragma unroll
                    for (int i = 0; i < 4; ++i) LPART[(wave * 32 + a * 16 + 4 * fq + i) * 48 + b * 16 + fr] = acc[a][b][i]; }
        __syncthreads();
#pragma unroll
        for (int q = 0; q < 3; ++q) { const int e = tid + NTHR * q; float s = 0.f;
#pragma unroll
            for (int w = 0; w < 8; ++w) s += LPART[w * 32 * 48 + e];
            LOG[e] = s * RSTD[e / 48]; }
        __syncthreads();
        LAS int* EL = (LAS int*)(LPART);
        float gA = 0.f, gB = 0.f; int e0 = 0, e1 = 0;
        if (tid < 32) { const LAS float* lg = LOG + tid * 48; const float* gb = INF(I_MGB) + l * 4; const float* eb = INF(I_MEB) + l * 32;
            float gmax = -3.0e38f; int gi = 0;
            for (int i = 0; i < 4; ++i) { const float v = lg[i] + gb[i]; if (v > gmax) { gmax = v; gi = i; } }
            float gden = 0.f;
            for (int i = 0; i < 4; ++i) gden += __expf(lg[i] + gb[i] - gmax);
            const float gg = 1.0f / gden;
            float b1 = -3.0e38f; int i1 = 0;
            for (int i = 0; i < 8; ++i) { const float v = lg[4 + gi * 8 + i] + eb[gi * 8 + i]; if (v > b1) { b1 = v; i1 = i; } }
            float b2 = -3.0e38f; int i2 = 0;
            for (int i = 0; i < 8; ++i) { const float v = lg[4 + gi * 8 + i] + eb[gi * 8 + i]; if (i != i1 && v > b2) { b2 = v; i2 = i; } }
            const float wA = 1.0f / (1.0f + __expf(b2 - b1)), wB = 1.0f - wA;
            e0 = gi * 8 + i1; e1 = gi * 8 + i2; gA = gg * wA; gB = gg * wB;
            EL[tid] = e0; EL[32 + tid] = e1; }
        __syncthreads();
        if (tid < 32) {
            int r0 = 0, r1 = 0, cnt = 0;
            for (int t2 = 0; t2 < 32; ++t2) { const int a0 = EL[t2], a1 = EL[32 + t2];
                if (t2 < tid) { r0 += (a0 == e0) + (a1 == e0); r1 += (a0 == e1) + (a1 == e1); }
                cnt += (a0 == tid) + (a1 == tid); }
            const size_t m = (size_t)m0 + tid;
            ROUTE[m * 4 + 0] = e0; ROUTE[m * 4 + 1] = e1; ROUTE[m * 4 + 2] = r0; ROUTE[m * 4 + 3] = r1;
            GATE[m * 2] = gA; GATE[m * 2 + 1] = gB;
            CNT[(size_t)tb * 32 + tid] = (unsigned)cnt; }
        __syncthreads();
    }
}

__device__ __forceinline__ void compute_toff(CArgs Ap, int l, LAS unsigned char* lds, int tb) {
    const int tid = otid();
    const unsigned* CNT = (const unsigned*)(Ap->ws + WS_CTL) + CW_CNT + 8192 * l;
    LAS int* TOFF = (LAS int*)(lds + MISC_OFF + 64); LAS int* CL = TOFF + 40; LAS int* BASE = TOFF + 176; LAS int* PART = (LAS int*)lds;
    __syncthreads();
    { const int e = tid & 31, part = tid >> 5; int tot = 0, bs = 0;
        for (int i = 0; i < 16; ++i) { const int b = part * 16 + i; const int c = (int)CNT[(size_t)b * 32 + e]; tot += c; if (b < tb) bs += c; }
        PART[part * 32 + e] = tot; PART[512 + part * 32 + e] = bs; }
    __syncthreads();
    if (tid < 32) { int tot = 0, bs = 0; for (int p = 0; p < 16; ++p) { tot += PART[p * 32 + tid]; bs += PART[512 + p * 32 + tid]; } CL[tid] = tot; BASE[tid] = bs; }
    __syncthreads();
    if (tid == 0) { int acc = 0; for (int e = 0; e < 32; ++e) { TOFF[e] = acc; acc += (CL[e] + 255) >> 8; } TOFF[32] = acc; }
    __syncthreads();
    if (tid < 96) { int e = 0; for (int j = 1; j < 32; ++j) e += (TOFF[j] <= tid) ? 1 : 0; TOFF[80 + tid] = e; }
    __syncthreads();
}
__device__ __forceinline__ void phase_r2(CArgs Ap, int l, LAS unsigned char* lds) {
    const int* ROUTE = (const int*)(Ap->ws + WS_ROUTE); int* POS = (int*)(Ap->ws + WS_POS); int* ROWTOK = (int*)(Ap->ws + WS_ROWTOK);
    LAS int* TOFF = (LAS int*)(lds + MISC_OFF + 64); LAS int* CL = TOFF + 40; LAS int* BASE = TOFF + 176;
    for (int tb = blockIdx.x; tb < NTOK / 32; tb += gridDim.x) {
        compute_toff(Ap, l, lds, tb);
        const int tid = otid();
        if (tid < 32) { const int m = tb * 32 + tid;
            const int e0 = ROUTE[m * 4], e1 = ROUTE[m * 4 + 1], r0 = ROUTE[m * 4 + 2], r1 = ROUTE[m * 4 + 3];
            const int d0 = TOFF[e0] * 256 + BASE[e0] + r0, d1 = TOFF[e1] * 256 + BASE[e1] + r1;
            POS[2 * m] = d0; POS[2 * m + 1] = d1; ROWTOK[d0] = m; ROWTOK[d1] = m; }
        if (tb < 32) { const int lo = TOFF[tb] * 256 + CL[tb], hi = TOFF[tb + 1] * 256;
            for (int p = lo + tid; p < hi; p += NTHR) ROWTOK[p] = 0; }
        __syncthreads();
    }
}

typedef short bf16x8_t __attribute__((ext_vector_type(8)));
__device__ __forceinline__ void lds_barrier() { asm volatile("s_waitcnt lgkmcnt(0)" ::: "memory"); __builtin_amdgcn_s_barrier(); asm volatile("" ::: "memory"); }
__device__ __forceinline__ LAS unsigned char* vbase(LAS unsigned char* p) { unsigned a = (unsigned)(size_t)p; asm volatile("" : "+v"(a)); return (LAS unsigned char*)(size_t)a; }
constexpr int CH = 64, NCHUNK = SEQ / CH;

template <int DK, int DV, bool HAS_AB, bool BSK = false> struct Blob {
    static constexpr int ABAR = 0;
    static constexpr int MBAR = ABAR + (HAS_AB ? 64 * DK * 2 : 0);
    static constexpr int BDT = MBAR + (HAS_AB ? 64 * 64 * 2 : 0);
    static constexpr int NRB = BDT + ((HAS_AB && !BSK) ? DK * 64 * 2 : 0);
    static constexpr int KDT = NRB + ((HAS_AB && !BSK) ? 64 * 64 * 2 : 0);
    static constexpr int VT = KDT + DK * 64 * 2;
    static constexpr int RT = VT + DV * 64 * 2;
    static constexpr int NRK = RT + 64 * DK * 2;
    static constexpr int SVEC = NRK + 64 * 64 * 2;
    static constexpr int BYTES = SVEC + (BSK ? 256 : 0);
};
typedef Blob<64, 64, true> BlobW;
typedef Blob<128, 128, true, true> BlobG;
typedef Blob<128, 128, false> BlobR;

__device__ __forceinline__ void mm16(f32x4& acc, const LAS bf16* A, int sa, int m0, const LAS bf16* B, int sb, int n0, int K, int lane) {
    const int fr = lane & 15, fq = lane >> 4;
    const LAS bf16* pa = A + (m0 + fr) * sa + fq * 8; const LAS bf16* pb = B + (n0 + fr) * sb + fq * 8;
    for (int k = 0; k < K; k += 32) { const bf16x8_t a = *(const LAS bf16x8_t*)(pa + k); const bf16x8_t b = *(const LAS bf16x8_t*)(pb + k);
        acc = __builtin_amdgcn_mfma_f32_16x16x32_bf16(a, b, acc, 0, 0, 0); }
}
__device__ __forceinline__ v2u pack4(f32x4 v) { v2u o; o.x = pk2h(v[0], v[1]); o.y = pk2h(v[2], v[3]); return o; }

template <int ROWS, int LEN8> __device__ __forceinline__ void img_out(unsigned char* g, const LAS unsigned char* l, int sb, int tid) {
#pragma unroll
    for (int q = 0; q < (ROWS * LEN8 + NTHR - 1) / NTHR; ++q) { const int p = tid + NTHR * q; if (p < ROWS * LEN8) { const int row = p / LEN8, c = p % LEN8; *(v4u*)(g + (size_t)p * 16) = *(const LAS v4u*)(l + row * sb + c * 16); } }
}
template <int ROWS, int LEN8> struct ImgPref {
    static constexpr int NP = (ROWS * LEN8 + NTHR - 1) / NTHR;
    v4u r[NP];
    __device__ __forceinline__ void load(const unsigned char* g, int tid) {
#pragma unroll
        for (int q = 0; q < NP; ++q) { int p = tid + NTHR * q; if (ROWS * LEN8 % NTHR != 0) p = (p < ROWS * LEN8) ? p : 0; r[q] = *(const v4u*)(g + (size_t)p * 16); } }
    __device__ __forceinline__ void store(LAS unsigned char* l, int sb, int tid) const {
#pragma unroll
        for (int q = 0; q < NP; ++q) { const int p = tid + NTHR * q; if (p < ROWS * LEN8) { const int row = p / LEN8, c = p % LEN8; *(LAS v4u*)(l + row * sb + c * 16) = r[q]; } } }
};

__device__ __forceinline__ v4u pack8(const float (&v)[8]) { v4u o; o.x = pk2h(v[0], v[1]); o.y = pk2h(v[2], v[3]); o.z = pk2h(v[4], v[5]); o.w = pk2h(v[6], v[7]); return o; }
template <int DK, int DV, bool HAS_AB, bool PERCH, bool BSK, bool TCON  >
__device__ __forceinline__ void chunkA_rest(const float (&rA)[8][DK / 64], const float (&rB)[8][DK / 64], const float (&rK)[8][DK / 64], const float (&rR)[8][DK / 64],
                                            const float (&rV)[8][DV / 64], const float (&rLW)[8][DK / 64], const float (&rSV)[8], unsigned char* blob, float* pcg, LAS unsigned char* lds, int tid) {
    typedef Blob<DK, DV, HAS_AB, BSK> BL; static_assert(!BSK || (HAS_AB && !PERCH), "BSK is a scalar-decay mode");
    constexpr bool HAS_B = HAS_AB && !BSK;
    constexpr int NCH = DK / 64, NVC = DV / 64, SK = DK + 8, SC = 72, SKB = SK * 2, SCB = SC * 2;
    constexpr int LPB = PERCH ? 64 * DK * 4 : 512;
    constexpr int U0 = LPB;
    constexpr int O_BDT = U0, O_KDT = O_BDT + (HAS_B ? DK * SCB : 0), O_VT = O_KDT + DK * SCB;
    constexpr int O_IA = U0, O_IB = O_IA + (HAS_AB ? 64 * SKB : 0), O_IK = O_IB + (HAS_B ? 64 * SKB : 0), O_IR = O_IK + 64 * SKB, O_IAT = O_IR + 64 * SKB,
                  O_IMT = O_IAT + (HAS_AB ? DK * SCB : 0), O_IT = O_IMT + (HAS_AB ? 64 * SCB : 0), O_MAB = O_IT + (HAS_AB ? 64 * SCB : 0), O_XB = O_MAB + (HAS_AB ? 64 * 68 * 4 : 0), O_END = O_XB + (HAS_AB ? 64 * 20 * 4 : 0);
    static_assert(O_END <= RING_BYTES && O_VT + DV * SCB <= RING_BYTES, "phase A LDS map");
    const int lane = tid & 63, wave = __builtin_amdgcn_readfirstlane(tid >> 6);
    LAS float* LP = (LAS float*)vbase(lds);
    LAS unsigned char* const bBDT = vbase(lds + O_BDT); LAS unsigned char* const bKDT = vbase(lds + O_KDT); LAS unsigned char* const bVT = vbase(lds + O_VT);
    LAS unsigned char* const bIA = vbase(lds + O_IA); LAS unsigned char* const bIB = vbase(lds + O_IB); LAS unsigned char* const bIK = vbase(lds + O_IK); LAS unsigned char* const bIR = vbase(lds + O_IR);
    LAS unsigned char* const bIAT = vbase(lds + O_IAT); LAS unsigned char* const bIMT = vbase(lds + O_IMT); LAS unsigned char* const bIT = vbase(lds + O_IT); LAS unsigned char* const bMAB = vbase(lds + O_MAB); LAS unsigned char* const bXB = vbase(lds + O_XB);
    float eP[8][NCH], eN[8][NCH], eA[8][NCH], eD[8][NCH];
    if (PERCH) {
        static_assert(!PERCH || TCON, "the per-channel scan assumes consecutive tokens per wave");
        float pre[8][NCH];
#pragma unroll
        for (int q = 0; q < NCH; ++q) { float s = 0.f;
#pragma unroll
            for (int j = 0; j < 8; ++j) { s += rLW[j][q]; pre[j][q] = s; }
            LP[wave * DK + lane + 64 * q] = s; }
        lds_barrier();
#pragma unroll
        for (int q = 0; q < NCH; ++q) { const int c = lane + 64 * q; float off = 0.f, lpc = 0.f;
#pragma unroll
            for (int w = 0; w < 8; ++w) { const float tw = LP[w * DK + c]; lpc += tw; off += (w < wave) ? tw : 0.f; }
            if (wave == 7) pcg[c] = __expf(lpc);
#pragma unroll
            for (int j = 0; j < 8; ++j) { const float lp = off + pre[j][q], lpm = (j > 0) ? off + pre[j - 1][q] : off;
                eP[j][q] = __expf(lp); eN[j][q] = __expf(-lp); eA[j][q] = __expf(lpm); eD[j][q] = __expf(lpc - lp); } }
    } else {
        if (lane == 0) {
#pragma unroll
            for (int j = 0; j < 8; ++j) { const int t = TCON ? 8 * wave + j : wave + 8 * j; LP[t] = rLW[j][0]; if (BSK) LP[64 + t] = rSV[j]; } }
        lds_barrier();
        if (wave == 0) { float sc = LP[lane];
#define SCAN_SHR(ctl) sc += __builtin_bit_cast(float, __builtin_amdgcn_update_dpp(0, __builtin_bit_cast(int, sc), ctl, 0xf, 0xf, true))
            SCAN_SHR(0x111); SCAN_SHR(0x112); SCAN_SHR(0x114); SCAN_SHR(0x118);
#undef SCAN_SHR
            sc += __builtin_bit_cast(float, __builtin_amdgcn_update_dpp(0, __builtin_bit_cast(int, sc), 0x142, 0xa, 0xf, false));
            sc += __builtin_bit_cast(float, __builtin_amdgcn_update_dpp(0, __builtin_bit_cast(int, sc), 0x143, 0xc, 0xf, false));
            LP[lane] = sc; }
        lds_barrier();
#pragma unroll
        for (int q = 0; q < NCH; ++q) { const int c = lane + 64 * q; const float lpc = LP[63];
            if (wave == 7) pcg[c] = __expf(lpc);
#pragma unroll
            for (int j = 0; j < 8; ++j) { const int t = TCON ? 8 * wave + j : wave + 8 * j;
                const float lp = LP[t], lpm = (t > 0) ? LP[t - 1] : 0.f;
                eP[j][q] = __expf(lp); eN[j][q] = 1.f; eA[j][q] = __expf(lpm); eD[j][q] = __expf(lpc - lp); } }
    }
    if (TCON) {
#pragma unroll
        for (int q = 0; q < NCH; ++q) { const int c = lane + 64 * q; float tb[8], tk[8];
#pragma unroll
            for (int j = 0; j < 8; ++j) { tb[j] = rB[j][q] * eD[j][q]; tk[j] = rK[j][q] * eD[j][q];
                *(bf16*)(blob + BL::RT + (size_t)((8 * wave + j) * DK + c) * 2) = (bf16)f2bfh(rR[j][q] * eP[j][q]); }
            if (HAS_B) *(LAS v4u*)(bBDT + c * SCB + 16 * wave) = pack8(tb);
            *(LAS v4u*)(bKDT + c * SCB + 16 * wave) = pack8(tk); }
#pragma unroll
        for (int q = 0; q < NVC; ++q) { float tv[8];
#pragma unroll
            for (int j = 0; j < 8; ++j) tv[j] = rV[j][q];
            *(LAS v4u*)(bVT + (lane + 64 * q) * SCB + 16 * wave) = pack8(tv); }
    } else {
#pragma unroll
    for (int j = 0; j < 8; ++j) { const int t = wave + 8 * j;
#pragma unroll
        for (int q = 0; q < NCH; ++q) { const int c = lane + 64 * q;
            if (HAS_B) *(LAS bf16*)(bBDT + c * SCB + t * 2) = (bf16)f2bfh(rB[j][q] * eD[j][q]);
            *(LAS bf16*)(bKDT + c * SCB + t * 2) = (bf16)f2bfh(rK[j][q] * eD[j][q]);
            *(bf16*)(blob + BL::RT + (size_t)(t * DK + c) * 2) = (bf16)f2bfh(rR[j][q] * eP[j][q]); }
#pragma unroll
        for (int q = 0; q < NVC; ++q) *(LAS bf16*)(bVT + (lane + 64 * q) * SCB + t * 2) = (bf16)f2bfh(rV[j][q]); }
    }
    lds_barrier();
    if (HAS_B) img_out<DK, 8>(blob + BL::BDT, bBDT, SCB, tid);
    if (BSK && tid < 64) *(float*)(blob + BL::SVEC + tid * 4) = LP[64 + tid];
    img_out<DK, 8>(blob + BL::KDT, bKDT, SCB, tid);
    img_out<DV, 8>(blob + BL::VT, bVT, SCB, tid);
    lds_barrier();
#pragma unroll
    for (int q = 0; q < NCH; ++q) { const int c = lane + 64 * q; float ta[8];
#pragma unroll
        for (int j = 0; j < 8; ++j) { const int t = TCON ? 8 * wave + j : wave + 8 * j;
            const float ea = eA[j][q], en = eN[j][q], ep = PERCH ? eP[j][q] : 1.f;
            ta[j] = rA[j][q] * ea;
            if (HAS_AB) { *(LAS bf16*)(bIA + t * SKB + c * 2) = (bf16)f2bfh(PERCH ? ta[j] : rA[j][q]);
                if (HAS_B) *(LAS bf16*)(bIB + t * SKB + c * 2) = (bf16)f2bfh(rB[j][q] * en);
                if (!TCON) *(LAS bf16*)(bIAT + c * SCB + t * 2) = (bf16)f2bfh(ta[j]); }
            *(LAS bf16*)(bIK + t * SKB + c * 2) = (bf16)f2bfh(rK[j][q] * en);
            *(LAS bf16*)(bIR + t * SKB + c * 2) = (bf16)f2bfh(rR[j][q] * ep); }
        if (HAS_AB && TCON) *(LAS v4u*)(bIAT + c * SCB + 16 * wave) = pack8(ta); }
    lds_barrier();
    const int fr = lane & 15, fq = lane >> 4;
    const LAS bf16* IA = (const LAS bf16*)(bIA); const LAS bf16* IB = (const LAS bf16*)(bIB); const LAS bf16* IK = (const LAS bf16*)(bIK); const LAS bf16* IR = (const LAS bf16*)(bIR);
#define CA_TILE(prod, tile) do { const int mt = (tile) & 3, nt = (tile) >> 2; const int tt = nt * 16 + fr, jj0 = mt * 16 + 4 * fq; \
        if ((prod) == 2) { const int jp = tt; f32x4 acc = {0.f, 0.f, 0.f, 0.f}; mm16(acc, IA, SK, mt * 16, IK, SK, nt * 16, DK, lane); \
            _Pragma("unroll") for (int i = 0; i < 4; ++i) { const int jr = jj0 + i; float f; \
                if (PERCH) f = (jp < jr) ? 1.f : 0.f; else { const float lpm = (jr > 0) ? LP[jr - 1] : 0.f; f = (jp < jr) ? __expf(lpm - LP[jp]) : 0.f; } \
                acc[i] *= f; } \
            *(LAS v2u*)(bIMT + jp * SCB + jj0 * 2) = pack4(acc); } \
        else { float f_n[4], f_m[4]; \
            _Pragma("unroll") for (int i = 0; i < 4; ++i) { const int jj = jj0 + i; \
                if (PERCH) { f_n[i] = (jj <= tt) ? 1.f : 0.f; f_m[i] = (jj < tt) ? 1.f : 0.f; } \
                else { const float lpt = LP[tt], lpm = (tt > 0) ? LP[tt - 1] : 0.f, lpj = LP[jj]; \
                    f_n[i] = (jj <= tt) ? __expf(lpt - lpj) : 0.f; f_m[i] = (jj < tt) ? __expf(lpm - lpj) : 0.f; } } \
            if ((prod) == 0) { f32x4 acc = {0.f, 0.f, 0.f, 0.f}; mm16(acc, IK, SK, mt * 16, IR, SK, nt * 16, DK, lane); \
                _Pragma("unroll") for (int i = 0; i < 4; ++i) acc[i] *= f_n[i]; \
                *(v2u*)(blob + BL::NRK + (size_t)(tt * 64 + jj0) * 2) = pack4(acc); } \
            else if ((prod) == 1) { f32x4 acc = {0.f, 0.f, 0.f, 0.f}; mm16(acc, IB, SK, mt * 16, IR, SK, nt * 16, DK, lane); \
                _Pragma("unroll") for (int i = 0; i < 4; ++i) acc[i] *= f_n[i]; \
                *(v2u*)(blob + (HAS_B ? BL::NRB : 0) + (size_t)(tt * 64 + jj0) * 2) = pack4(acc); } \
            else { f32x4 acc = {0.f, 0.f, 0.f, 0.f}; mm16(acc, BSK ? IK : IB, SK, mt * 16, IA, SK, nt * 16, DK, lane); \
                _Pragma("unroll") for (int i = 0; i < 4; ++i) acc[i] *= f_m[i] * (BSK ? LP[64 + jj0 + i] : 1.f); \
                *(LAS f32x4*)(bMAB + (tt * 68 + jj0) * 4) = acc; } } } while (0)
    if (!HAS_AB) {
#pragma unroll
        for (int rep = 0; rep < 2; ++rep) CA_TILE(0, wave + 8 * rep);
    } else {
#pragma unroll
        for (int rep = 0; rep < 2; ++rep) CA_TILE(3, wave + 8 * rep);
    }
    if (HAS_AB) {
        lds_barrier();
        LAS float* const MAB = (LAS float*)(bMAB); LAS float* const XB = (LAS float*)(bXB);
        if (wave != 0) { constexpr int NIT = HAS_B ? 48 : 32;
#pragma unroll
            for (int k = 0; k < (NIT + 6) / 7; ++k) { const int w = wave - 1 + 7 * k;
                if (w < NIT) { const int pr = w >> 4, tile = w & 15;
                    if (pr == 0) CA_TILE(0, tile); else if (HAS_B && pr == 1) CA_TILE(1, tile); else CA_TILE(2, tile); } } }
        if (wave == 0) { const int blk = lane >> 4, col = lane & 15; LAS float* Mb = MAB + (16 * blk) * 68 + 16 * blk; float x[16];
#pragma unroll
            for (int r = 0; r < 16; ++r) x[r] = 0.f;
#pragma unroll
            for (int r = 0; r < 16; ++r) { float a0 = (r == col) ? 1.f : 0.f, a1 = 0.f;
#pragma unroll
                for (int s4 = 0; s4 < r; s4 += 4) { const f32x4 mm = *(const LAS f32x4*)(Mb + r * 68 + s4);
                    a0 += mm[0] * x[s4] + mm[2] * x[s4 + 2]; a1 += mm[1] * x[s4 + 1] + mm[3] * x[s4 + 3]; }
                x[r] = a0 + a1; }
            asm volatile("s_waitcnt lgkmcnt(0)" ::: "memory");
#pragma unroll
            for (int r = 0; r < 16; ++r) Mb[r * 68 + col] = x[r]; }
        lds_barrier();
        { const int fr_ = lane & 15, fq_ = lane >> 4;
#pragma unroll
        for (int a = 1; a < 4; ++a) { const int na = 16 * a;
            if (wave < a) { const int jt = wave; f32x4 acc = {0.f, 0.f, 0.f, 0.f};
#pragma unroll
                for (int s_ = 0; s_ < a; ++s_) { const int k0 = 16 * s_;
                    const f32x4 av = *(const LAS f32x4*)(MAB + (na + fr_) * 68 + k0 + 4 * fq_);
                    const float b0 = MAB[(k0 + 4 * fq_ + 0) * 68 + 16 * jt + fr_], b1 = MAB[(k0 + 4 * fq_ + 1) * 68 + 16 * jt + fr_], b2 = MAB[(k0 + 4 * fq_ + 2) * 68 + 16 * jt + fr_], b3 = MAB[(k0 + 4 * fq_ + 3) * 68 + 16 * jt + fr_];
                    acc = __builtin_amdgcn_mfma_f32_16x16x4f32(av[0], b0, acc, 0, 0, 0); acc = __builtin_amdgcn_mfma_f32_16x16x4f32(av[1], b1, acc, 0, 0, 0);
                    acc = __builtin_amdgcn_mfma_f32_16x16x4f32(av[2], b2, acc, 0, 0, 0); acc = __builtin_amdgcn_mfma_f32_16x16x4f32(av[3], b3, acc, 0, 0, 0); }
                *(LAS f32x4*)(XB + (16 * jt + fr_) * 20 + 4 * fq_) = acc; }
            lds_barrier();
            if (wave < a) { const int jt = wave; f32x4 acc = {0.f, 0.f, 0.f, 0.f};
                const f32x4 av = *(const LAS f32x4*)(MAB + (na + fr_) * 68 + na + 4 * fq_);
                const f32x4 bv = *(const LAS f32x4*)(XB + (16 * jt + fr_) * 20 + 4 * fq_);
                acc = __builtin_amdgcn_mfma_f32_16x16x4f32(av[0], bv[0], acc, 0, 0, 0); acc = __builtin_amdgcn_mfma_f32_16x16x4f32(av[1], bv[1], acc, 0, 0, 0);
                acc = __builtin_amdgcn_mfma_f32_16x16x4f32(av[2], bv[2], acc, 0, 0, 0); acc = __builtin_amdgcn_mfma_f32_16x16x4f32(av[3], bv[3], acc, 0, 0, 0);
#pragma unroll
                for (int i = 0; i < 4; ++i) MAB[(na + 4 * fq_ + i) * 68 + 16 * jt + fr_] = acc[i]; }
            lds_barrier(); } }
#pragma unroll
        for (int q = 0; q < 8; ++q) { const int e = tid + NTHR * q, t = e >> 6, j = e & 63; *(LAS bf16*)(bIT + t * SCB + j * 2) = (bf16)f2bfh(MAB[t * 68 + j]); }
        lds_barrier();
        const LAS bf16* IAT = (const LAS bf16*)(bIAT); const LAS bf16* IMT = (const LAS bf16*)(bIMT); const LAS bf16* IT = (const LAS bf16*)(bIT);
#pragma unroll
        for (int rep = 0; rep < DK / 32; ++rep) { const int tile = wave + 8 * rep, mt = tile % (DK / 16), nt = tile / (DK / 16);
            f32x4 acc = {0.f, 0.f, 0.f, 0.f}; mm16(acc, IAT, SC, mt * 16, IT, SC, nt * 16, 64, lane);
            *(v2u*)(blob + BL::ABAR + (size_t)((nt * 16 + fr) * DK + mt * 16 + 4 * fq) * 2) = pack4(acc); }
#pragma unroll
        for (int rep = 0; rep < 2; ++rep) { const int tile = wave + 8 * rep, mt = tile & 3, nt = tile >> 2;
            f32x4 acc = {0.f, 0.f, 0.f, 0.f}; mm16(acc, IMT, SC, mt * 16, IT, SC, nt * 16, 64, lane);
            *(v2u*)(blob + BL::MBAR + (size_t)((nt * 16 + fr) * 64 + mt * 16 + 4 * fq) * 2) = pack4(acc); }
    }
    lds_barrier();
}

struct RwkvIn { unsigned xr[9], xk[9], xv[9], xlw[8], xla[8], xlv[8]; float xvf[8]; };
__device__ __forceinline__ void rwkv_load(CArgs Ap, int l, int u, RwkvIn& X) {
    const int tid = otid(), lane = tid & 63, wave = __builtin_amdgcn_readfirstlane(tid >> 6);
    const int bh = u >> 5, chunk = u & 31, b = bh / 12, h = bh % 12, ch = h * 64 + lane;
    const bf16* PROJ = (const bf16*)(Ap->ws + WS_PROJ); const bf16* LR = (const bf16*)(Ap->ws + WS_LR); const float* VF = (const float*)(Ap->ws + WS_VF);
    const int tt0 = chunk * 64 + 8 * wave; const size_t m0 = (size_t)b * SEQ + tt0;
#pragma unroll
    for (int i = 0; i < 9; ++i) { const bool ok = (tt0 + i - 1) >= 0; const bf16* P = PROJ + (ok ? (m0 + i - 1) : m0) * NP;
        X.xr[i] = P[C_RR + ch]; X.xk[i] = P[C_RK + ch]; X.xv[i] = P[C_RV + ch]; }
#pragma unroll
    for (int j = 0; j < 8; ++j) { const size_t m = m0 + j; const bf16* L = LR + m * NLR;
        X.xlw[j] = L[ch]; X.xla[j] = L[768 + ch]; X.xlv[j] = (l > 0) ? (unsigned)L[1536 + ch] : 0u; X.xvf[j] = (l > 0) ? VF[m * 768 + ch] : 0.f; }
}
__device__ __forceinline__ void chunkA_rwkv(CArgs Ap, int l, int u, int un, RwkvIn& X, LAS unsigned char* lds) {
    const int tid = otid(), lane = tid & 63, wave = __builtin_amdgcn_readfirstlane(tid >> 6);
    const int bh = u >> 5, chunk = u & 31, b = bh / 12, h = bh % 12, ch = h * 64 + lane;
    float* VF = (float*)(Ap->ws + WS_VF); float* BON = (float*)(Ap->ws + WS_BON);
    const float mu_r = INF(I_MU_RKVG)[(l * 4 + 0) * 768 + ch], mu_k = INF(I_MU_RKVG)[(l * 4 + 1) * 768 + ch], mu_v = INF(I_MU_RKVG)[(l * 4 + 2) * 768 + ch];
    const float w0 = INF(I_W0)[l * 768 + ch], a0 = INF(I_A0)[l * 768 + ch], kkc = INF(I_KK)[l * 768 + ch], kac = INF(I_KA)[l * 768 + ch], rkc = INF(I_RK)[l * 768 + ch];
    const float v0c = (l > 0) ? INF(I_V0)[ch] : 0.f;
    float rA[8][1], rB[8][1], rK[8][1], rR[8][1], rV[8][1], rLW[8][1];
    const int tt0 = chunk * 64 + 8 * wave; const size_t m0 = (size_t)b * SEQ + tt0;
    float xr[9], xk[9], xv[9];
#pragma unroll
    for (int i = 0; i < 9; ++i) { const float mk = ((tt0 + i - 1) >= 0) ? 1.f : 0.f; xr[i] = mk * bf2f((bf16)X.xr[i]); xk[i] = mk * bf2f((bf16)X.xk[i]); xv[i] = mk * bf2f((bf16)X.xv[i]); }
#pragma unroll
    for (int j = 0; j < 8; ++j) { const size_t m = m0 + j;
        const float r = xr[j + 1] + (xr[j] - xr[j + 1]) * mu_r, k = xk[j + 1] + (xk[j] - xk[j + 1]) * mu_k; float v = xv[j + 1] + (xv[j] - xv[j + 1]) * mu_v;
        const float lw = -0.6065306597126334f * sigmoidf_(w0 + bf2f((bf16)X.xlw[j]));
        const float a = sigmoidf_(a0 + bf2f((bf16)X.xla[j]));
        if (l == 0) VF[m * 768 + ch] = v; else v = v + (X.xvf[j] - v) * sigmoidf_(v0c + bf2f((bf16)X.xlv[j]));
        const float kkr = k * kkc; const float kk = kkr * rsqrtf(wave_sum(kkr * kkr) + 1e-6f);
        const float k2 = k * (1.0f + (a - 1.0f) * kac);
        const float bon = wave_sum(r * k2 * rkc);
        if (lane == 0) BON[m * 12 + h] = bon;
        rA[j][0] = -kk; rB[j][0] = kk * a; rK[j][0] = k2; rR[j][0] = r; rV[j][0] = v; rLW[j][0] = lw; }
    rwkv_load(Ap, l, un, X);
    const float rSV[8] = {0.f, 0.f, 0.f, 0.f, 0.f, 0.f, 0.f, 0.f};
    chunkA_rest<64, 64, true, true, false, true>(rA, rB, rK, rR, rV, rLW, rSV, Ap->ws + WS_BLOBW + (size_t)u * BlobW::BYTES, (float*)(Ap->ws + WS_PCS) + (size_t)u * 64, lds, tid);
}
__device__ __forceinline__ void chunkA_gdn(CArgs Ap, int l, int u, LAS unsigned char* lds) {
    const int tid = otid(), lane = tid & 63, wave = __builtin_amdgcn_readfirstlane(tid >> 6);
    const int bh = u >> 5, chunk = u & 31, b = bh / 6, h = bh % 6;
    const bf16* PROJ = (const bf16*)(Ap->ws + WS_PROJ);
    const float* cw = INF(I_CONVW) + (size_t)l * 4 * 2304;
    const int cq0 = h * 128 + lane, cq1 = cq0 + 64, ck0 = 768 + cq0, ck1 = 768 + cq1, cv0 = 1536 + cq0, cv1 = 1536 + cq1;
    float wq0[4], wq1[4], wk0[4], wk1[4], wv0[4], wv1[4];
#pragma unroll
    for (int j = 0; j < 4; ++j) { wq0[j] = cw[j * 2304 + cq0]; wq1[j] = cw[j * 2304 + cq1]; wk0[j] = cw[j * 2304 + ck0]; wk1[j] = cw[j * 2304 + ck1]; wv0[j] = cw[j * 2304 + cv0]; wv1[j] = cw[j * 2304 + cv1]; }
    const float Aneg = -__expf(INF(I_ALOG)[l * 6 + h]), dtb = INF(I_DTB)[l * 6 + h];
    float rA[8][2], rB[8][2], rK[8][2], rR[8][2], rV[8][2], rLW[8][2], rSV[8];
    {
        const int tt0 = chunk * 64 + 8 * wave; const size_t m0 = (size_t)b * SEQ + tt0;
        float xq[11][2], xk[11][2], xv[11][2], xda[8], xdb[8];
#pragma unroll
        for (int i = 0; i < 11; ++i) { const bool ok = (tt0 + i - 3) >= 0; const float mk = ok ? 1.f : 0.f; const bf16* P = PROJ + (ok ? (m0 + i - 3) : m0) * NP + C_DQ;
            xq[i][0] = mk * bf2f(P[cq0]); xq[i][1] = mk * bf2f(P[cq1]); xk[i][0] = mk * bf2f(P[ck0]); xk[i][1] = mk * bf2f(P[ck1]); xv[i][0] = mk * bf2f(P[cv0]); xv[i][1] = mk * bf2f(P[cv1]); }
#pragma unroll
        for (int j = 0; j < 8; ++j) { const bf16* P = PROJ + (m0 + j) * NP; xda[j] = bf2f(P[C_DA + h]); xdb[j] = bf2f(P[C_DB + h]); }
#pragma unroll
        for (int j = 0; j < 8; ++j) {
            float q0 = 0.f, q1 = 0.f, k0 = 0.f, k1 = 0.f, v0 = 0.f, v1 = 0.f;
#pragma unroll
            for (int jj = 0; jj < 4; ++jj) { q0 += wq0[jj] * xq[j + jj][0]; q1 += wq1[jj] * xq[j + jj][1]; k0 += wk0[jj] * xk[j + jj][0]; k1 += wk1[jj] * xk[j + jj][1]; v0 += wv0[jj] * xv[j + jj][0]; v1 += wv1[jj] * xv[j + jj][1]; }
            q0 = siluf_(q0); q1 = siluf_(q1); k0 = siluf_(k0); k1 = siluf_(k1); v0 = siluf_(v0); v1 = siluf_(v1);
            const float qs = rsqrtf(wave_sum(q0 * q0 + q1 * q1) + 1e-6f) * 0.08838834764831845f, ksn = rsqrtf(wave_sum(k0 * k0 + k1 * k1) + 1e-6f);
            k0 *= ksn; k1 *= ksn;
            const float x = xda[j] + dtb; const float sp = (x > 20.f) ? x : __logf(1.0f + __expf(x));
            const float g = Aneg * sp, al = __expf(g), be = sigmoidf_(xdb[j]);
            rA[j][0] = k0; rA[j][1] = k1; rB[j][0] = -al * be * k0; rB[j][1] = -al * be * k1; rK[j][0] = k0; rK[j][1] = k1; rR[j][0] = q0 * qs; rR[j][1] = q1 * qs;
            rV[j][0] = be * v0; rV[j][1] = be * v1; rLW[j][0] = g; rLW[j][1] = g; rSV[j] = -al * be; } }
    chunkA_rest<128, 128, true, false, true, true>(rA, rB, rK, rR, rV, rLW, rSV, Ap->ws + WS_BLOBG + (size_t)u * BlobG::BYTES, (float*)(Ap->ws + WS_PCS) + 1536 * 64 + (size_t)u * 128, lds, tid);
}
__device__ __forceinline__ void chunkA_ret(CArgs Ap, int l, int u, LAS unsigned char* lds) {
    const int tid = otid(), lane = tid & 63, wave = __builtin_amdgcn_readfirstlane(tid >> 6);
    const int bh = u >> 5, chunk = u & 31, b = bh / 4, h = bh % 4;
    const bf16* PROJ = (const bf16*)(Ap->ws + WS_PROJ); const int* POSI = (const int*)Ap->in[I_POS];
    const double inv_freq = (double)exp2f(-(float)lane * (13.287712379549449f / 64.0f));
    const float lgam = __logf(1.0f - exp2f(-5.0f - (float)h));
    float rA[8][2], rB[8][2], rK[8][2], rR[8][2], rV[8][2], rLW[8][2];
#pragma unroll
    for (int j = 0; j < 8; ++j) { const int t = 8 * wave + j, tt = chunk * 64 + t; const size_t m = (size_t)b * SEQ + tt;
        const bf16* P = PROJ + m * NP;
        const double xd = (double)POSI[m] * inv_freq * 0.15915494309189535; const float fr = (float)(xd - __builtin_rint(xd));
        const float sn = __builtin_amdgcn_sinf(fr), cs = __builtin_amdgcn_cosf(fr);
        const float q1 = bf2f(P[C_TQ + h * 128 + lane]), q2 = bf2f(P[C_TQ + h * 128 + 64 + lane]);
        const float k1 = bf2f(P[C_TK + h * 128 + lane]) * 0.08838834764831845f, k2 = bf2f(P[C_TK + h * 128 + 64 + lane]) * 0.08838834764831845f;
        rR[j][0] = q1 * cs - q2 * sn; rR[j][1] = q1 * sn + q2 * cs; rK[j][0] = k1 * cs - k2 * sn; rK[j][1] = k1 * sn + k2 * cs;
        rV[j][0] = bf2f(P[C_TV + h * 128 + lane]); rV[j][1] = bf2f(P[C_TV + h * 128 + 64 + lane]);
        rA[j][0] = 0.f; rA[j][1] = 0.f; rB[j][0] = 0.f; rB[j][1] = 0.f; rLW[j][0] = lgam; rLW[j][1] = lgam; }
    const float rSV[8] = {0.f, 0.f, 0.f, 0.f, 0.f, 0.f, 0.f, 0.f};
    chunkA_rest<128, 128, false, false, false, true>(rA, rB, rK, rR, rV, rLW, rSV, Ap->ws + WS_BLOBR + (size_t)u * BlobR::BYTES, (float*)(Ap->ws + WS_PCS) + 1536 * 64 + 768 * 128 + (size_t)u * 128, lds, tid);
}
__device__ __forceinline__ void phase_mixA(CArgs Ap, int l, LAS unsigned char* lds) {
    for (int u = blockIdx.x; u < 768; u += gridDim.x) chunkA_gdn(Ap, l, u, lds);
    { RwkvIn X; const int u0 = blockIdx.x; if (u0 < 1536) rwkv_load(Ap, l, u0, X);
      for (int u = u0; u < 1536; u += gridDim.x) { const int un = (u + (int)gridDim.x < 1536) ? u + (int)gridDim.x : u; chunkA_rwkv(Ap, l, u, un, X, lds); } }
    for (int u = blockIdx.x; u < 512; u += gridDim.x) chunkA_ret(Ap, l, u, lds);
}

template <int DK, int DV, bool HAS_AB, int NS, bool BSK>
__device__ __forceinline__ void passB(const unsigned char* blob0, const float* pc0, int slice, bf16* oraw, LAS unsigned char* lds) {
    typedef Blob<DK, DV, HAS_AB, BSK> BL; constexpr bool HAS_B = HAS_AB && !BSK;
    constexpr int SK = DK + 8, SC = 72, SKB = SK * 2, SCB = SC * 2, NMT = DK / 16, NNT = NS / 16;
    constexpr int NST = NMT * NNT / 8, NUT = 4 * NNT / 8, NOT = NNT * 4 / 8;
    constexpr int O_ABAR = 0, O_MBAR = O_ABAR + (HAS_AB ? 64 * SKB : 0), O_BDT = O_MBAR + (HAS_AB ? 64 * SCB : 0), O_NRB = O_BDT + (HAS_B ? DK * SCB : 0), O_KDT = O_NRB + (HAS_B ? 64 * SCB : 0),
                  O_VT = O_KDT + DK * SCB, O_RT = O_VT + NS * SCB, O_NRK = O_RT + 64 * SKB, O_S0T = O_NRK + 64 * SCB, O_UT = O_S0T + NS * SKB, O_PC = O_UT + (HAS_AB ? NS * SCB : 0), O_SV = O_PC + DK * 4, O_END1 = O_SV + (BSK ? 256 : 0);
    constexpr bool DB = HAS_AB;
    constexpr int O_KDT2 = O_END1, O_NRK2 = O_KDT2 + (DB ? DK * SCB : 0), O_PC2 = O_NRK2 + (DB ? 64 * SCB : 0), O_BDT2 = O_PC2 + (DB ? DK * 4 : 0), O_NRB2 = O_BDT2 + (DB && HAS_B ? DK * SCB : 0), O_VT2 = O_NRB2 + (DB && HAS_B ? 64 * SCB : 0), O_END = O_VT2 + (DB && HAS_B ? NS * SCB : 0);
    static_assert(O_END <= MISC_OFF && NST >= 1 && NUT >= 1, "pass B LDS map / tiling");
    const int tid = otid(), lane = tid & 63, wave = __builtin_amdgcn_readfirstlane(tid >> 6), fr = lane & 15, fq = lane >> 4;
    LAS unsigned char* const qABAR = vbase(lds + O_ABAR); LAS unsigned char* const qMBAR = vbase(lds + O_MBAR); LAS unsigned char* const qBDT_0 = vbase(lds + O_BDT); LAS unsigned char* const qNRB_0 = vbase(lds + O_NRB); LAS unsigned char* const qKDT_0 = vbase(lds + O_KDT); LAS unsigned char* const qVT_0 = vbase(lds + O_VT);
    LAS unsigned char* const qBDT_1 = vbase(lds + (DB && HAS_B ? O_BDT2 : O_BDT)); LAS unsigned char* const qNRB_1 = vbase(lds + (DB && HAS_B ? O_NRB2 : O_NRB)); LAS unsigned char* const qKDT_1 = vbase(lds + (DB ? O_KDT2 : O_KDT)); LAS unsigned char* const qVT_1 = vbase(lds + (DB && HAS_B ? O_VT2 : O_VT)); LAS unsigned char* const qRT = vbase(lds + O_RT); LAS unsigned char* const qNRK_0 = vbase(lds + O_NRK); LAS unsigned char* const qNRK_1 = vbase(lds + (DB ? O_NRK2 : O_NRK)); LAS unsigned char* const qS0T = vbase(lds + O_S0T); LAS unsigned char* const qUT = vbase(lds + O_UT); LAS unsigned char* const qPC_0 = vbase(lds + O_PC); LAS unsigned char* const qPC_1 = vbase(lds + (DB ? O_PC2 : O_PC)); LAS unsigned char* const qSV = vbase(lds + O_SV);
    f32x4 S[NST];
#pragma unroll
    for (int i = 0; i < NST; ++i) S[i] = (f32x4){0.f, 0.f, 0.f, 0.f};
    ImgPref<64, DK / 8> pA_0, pA_1; ImgPref<64, 8> pM_0, pM_1; ImgPref<DK, 8> pBd_0, pBd_1; ImgPref<64, 8> pNb_0, pNb_1; ImgPref<DK, 8> pKd_0, pKd_1; ImgPref<NS, 8> pV_0, pV_1; ImgPref<64, DK / 8> pR_0, pR_1; ImgPref<64, 8> pNk_0, pNk_1;
    float pcr_0 = 0.f, pcr_1 = 0.f, svr_0 = 0.f, svr_1 = 0.f;
#define PB_LOAD(S, cn) do { const int cc_ = ((cn) < NCHUNK) ? (cn) : (NCHUNK - 1); const unsigned char* bl_ = blob0 + (size_t)cc_ * BL::BYTES; \
        if (HAS_AB) { pA_##S.load(bl_ + BL::ABAR, tid); pM_##S.load(bl_ + BL::MBAR, tid); } if (HAS_B) { pBd_##S.load(bl_ + BL::BDT, tid); pNb_##S.load(bl_ + BL::NRB, tid); } \
        if (BSK) svr_##S = *(const float*)(bl_ + BL::SVEC + (tid & 63) * 4); \
        pKd_##S.load(bl_ + BL::KDT, tid); pV_##S.load(bl_ + BL::VT + slice * NS * 128, tid); pR_##S.load(bl_ + BL::RT, tid); pNk_##S.load(bl_ + BL::NRK, tid); \
        pcr_##S = pc0[(size_t)cc_ * DK + (tid & (DK - 1))]; } while (0)
#define PB_STORE(S, P) do { if (HAS_AB) { pA_##S.store(qABAR, SKB, tid); pM_##S.store(qMBAR, SCB, tid); } if (HAS_B) { pBd_##S.store(qBDT_##P, SCB, tid); pNb_##S.store(qNRB_##P, SCB, tid); } \
        if (BSK && tid < 64) *(LAS float*)(qSV + tid * 4) = svr_##S; \
        pKd_##S.store(qKDT_##P, SCB, tid); pV_##S.store(qVT_##P, SCB, tid); pR_##S.store(qRT, SKB, tid); pNk_##S.store(qNRK_##P, SCB, tid); \
        if (tid < DK) *(LAS float*)(qPC_##P + tid * 4) = pcr_##S; } while (0)
    PB_LOAD(0, 0); PB_STORE(0, 0); PB_LOAD(0, 1);
    const LAS bf16* ABARs = (const LAS bf16*)(qABAR); const LAS bf16* MBARs = (const LAS bf16*)(qMBAR); const LAS bf16* BDTs_0 = (const LAS bf16*)(qBDT_0); const LAS bf16* NRBs_0 = (const LAS bf16*)(qNRB_0); const LAS bf16* BDTs_1 = (const LAS bf16*)(qBDT_1); const LAS bf16* NRBs_1 = (const LAS bf16*)(qNRB_1);
    const LAS bf16* KDTs_0 = (const LAS bf16*)(qKDT_0); const LAS bf16* VTs_0 = (const LAS bf16*)(qVT_0); const LAS bf16* NRKs_0 = (const LAS bf16*)(qNRK_0); const LAS bf16* KDTs_1 = (const LAS bf16*)(qKDT_1); const LAS bf16* VTs_1 = (const LAS bf16*)(qVT_1); const LAS bf16* NRKs_1 = (const LAS bf16*)(qNRK_1); const LAS bf16* RTs = (const LAS bf16*)(qRT);
    const LAS bf16* S0T = (const LAS bf16*)(qS0T); const LAS bf16* UT = (const LAS bf16*)(qUT);
#define PB_S0T() do { _Pragma("unroll") for (int i = 0; i < NST; ++i) { const int tile = wave + 8 * i, mt = tile % NMT, nt = tile / NMT; \
        *(LAS v2u*)(qS0T + (nt * 16 + fr) * SKB + (mt * 16 + 4 * fq) * 2) = pack4(S[i]); } } while (0)
#define PB_CHUNK(cn_, P) do { \
        f32x4 oacc[NOT]; \
        _Pragma("unroll") for (int i = 0; i < NOT; ++i) { const int tile = wave + 8 * i, mt2 = tile % NNT, nt2 = tile / NNT; oacc[i] = (f32x4){0.f, 0.f, 0.f, 0.f}; \
            mm16(oacc[i], S0T, SK, mt2 * 16, RTs, SK, nt2 * 16, DK, lane); \
            if (!BSK) mm16(oacc[i], VTs_##P, SC, mt2 * 16, NRKs_##P, SC, nt2 * 16, 64, lane); } \
        if (HAS_AB) { \
            _Pragma("unroll") for (int i = 0; i < NUT; ++i) { const int tile = wave + 8 * i, mt = tile & 3, nt = tile >> 2; f32x4 uacc = {0.f, 0.f, 0.f, 0.f}; \
                mm16(uacc, ABARs, SK, mt * 16, S0T, SK, nt * 16, DK, lane); \
                mm16(uacc, MBARs, SC, mt * 16, VTs_##P, SC, nt * 16, 64, lane); \
                if (BSK) { const f32x4 sv = *(const LAS f32x4*)(qSV + (mt * 16 + 4 * fq) * 4); const v2u vv = *(const LAS v2u*)(qVT_##P + (nt * 16 + fr) * SCB + (mt * 16 + 4 * fq) * 2); \
                    uacc[0] = sv[0] * uacc[0] + bf2f((bf16)(vv.x & 0xffff)); uacc[1] = sv[1] * uacc[1] + bf2f((bf16)(vv.x >> 16)); uacc[2] = sv[2] * uacc[2] + bf2f((bf16)(vv.y & 0xffff)); uacc[3] = sv[3] * uacc[3] + bf2f((bf16)(vv.y >> 16)); } \
                *(LAS v2u*)(qUT + (nt * 16 + fr) * SCB + (mt * 16 + 4 * fq) * 2) = pack4(uacc); } \
            lds_barrier(); \
            _Pragma("unroll") for (int i = 0; i < NOT; ++i) { const int tile = wave + 8 * i, mt2 = tile % NNT, nt2 = tile / NNT; mm16(oacc[i], UT, SC, mt2 * 16, BSK ? NRKs_##P : NRBs_##P, SC, nt2 * 16, 64, lane); } } \
        _Pragma("unroll") for (int i = 0; i < NOT; ++i) { const int tile = wave + 8 * i, mt2 = tile % NNT, nt2 = tile / NNT; \
            *(v2u*)(oraw + (size_t)((cn_) * 64 + nt2 * 16 + fr) * DM + mt2 * 16 + 4 * fq) = pack4(oacc[i]); } \
        _Pragma("unroll") for (int i = 0; i < NST; ++i) { const int tile = wave + 8 * i, mt = tile % NMT, nt = tile / NMT; \
            const f32x4 pc = *(const LAS f32x4*)(qPC_##P + (mt * 16 + 4 * fq) * 4); \
            f32x4 s_ = S[i] * pc; \
            if (HAS_B) mm16(s_, BDTs_##P, SC, mt * 16, UT, SC, nt * 16, 64, lane); \
            mm16(s_, KDTs_##P, SC, mt * 16, BSK ? UT : VTs_##P, SC, nt * 16, 64, lane); \
            S[i] = s_; } \
        if (!DB) lds_barrier(); } while (0)
    PB_S0T();
    lds_barrier();
#pragma unroll 1
    for (int cn = 0; cn < NCHUNK; cn += 2) {
        PB_LOAD(1, cn + 2); PB_CHUNK(cn, 0);     PB_S0T(); PB_STORE(0, 1); lds_barrier();
        PB_LOAD(0, cn + 3); PB_CHUNK(cn + 1, 1); PB_S0T(); PB_STORE(1, 0); lds_barrier();
    }
#undef PB_S0T
#undef PB_CHUNK
#undef PB_LOAD
#undef PB_STORE
}
__device__ __forceinline__ void phase_mixB(CArgs Ap, int l, LAS unsigned char* lds) {
    bf16* ORAW = (bf16*)(Ap->ws + WS_ORAW); const float* PCS = (const float*)(Ap->ws + WS_PCS);
    for (int u = blockIdx.x; u < 256; u += gridDim.x) {
        if (u < 96) { const int v = u, y = v >> 3, bh = (v & 7) + 8 * (y >> 1), slice = y & 1, b = bh / 12, h = bh % 12;
            passB<64, 64, true, 32, false>(Ap->ws + WS_BLOBW + (size_t)bh * 32 * BlobW::BYTES, PCS + (size_t)bh * 32 * 64, slice, ORAW + (size_t)b * SEQ * DM + h * 64 + slice * 32, lds); }
        else if (u < 192) { const int v = u - 96, y = v >> 3, bh = (v & 7) + 8 * (y >> 2), slice = y & 3, b = bh / 6, h = bh % 6;
            passB<128, 128, true, 32, true>(Ap->ws + WS_BLOBG + (size_t)bh * 32 * BlobG::BYTES, PCS + 1536 * 64 + (size_t)bh * 32 * 128, slice, ORAW + (size_t)b * SEQ * DM + 1280 + h * 128 + slice * 32, lds); }
        else { const int v = u - 192, y = v >> 3, bh = (v & 7) + 8 * (y >> 2), slice = y & 3, b = bh / 4, h = bh % 4;
            passB<128, 128, false, 32, false>(Ap->ws + WS_BLOBR + (size_t)bh * 32 * BlobR::BYTES, PCS + 1536 * 64 + 768 * 128 + (size_t)bh * 32 * 128, slice, ORAW + (size_t)b * SEQ * DM + 768 + h * 128 + slice * 32, lds); }
    }
    if (gridDim.x == 256) { __syncthreads();
        if (blockIdx.x >= 192) phase_convert<2>(Ap, l, lds, (int)blockIdx.x - 192, 64, 0, 6144); else if (blockIdx.x < 96) phase_convert<2>(Ap, l, lds, (int)blockIdx.x, 96, 6144, 8192); }
    else { __syncthreads(); phase_convert<2>(Ap, l, lds, (int)blockIdx.x, (int)gridDim.x); }
}

__device__ __forceinline__ void phase_m2c(CArgs Ap, int l) {
    const int wave = __builtin_amdgcn_readfirstlane(otid() >> 6);
    const int gw = blockIdx.x * NWAVES + wave, NGW = gridDim.x * NWAVES;
    const bf16* PROJ = (const bf16*)(Ap->ws + WS_PROJ); const bf16* ORAW = (const bf16*)(Ap->ws + WS_ORAW); bf16* MIX = (bf16*)(Ap->ws + WS_MIX);
    const bf16* LR = (const bf16*)(Ap->ws + WS_LR); const float* VF = (const float*)(Ap->ws + WS_VF); const float* BON = (const float*)(Ap->ws + WS_BON);
    for (int m = gw; m < NTOK; m += NGW) { const int lane = otid() & 63, hq = lane >> 4, sub = lane & 15;
        const bool hp = (m % SEQ) > 0; const float hpf = hp ? 1.f : 0.f;
        const bf16* P = PROJ + (size_t)m * NP; const bf16* Pp = hp ? P - NP : P; const bf16* O = ORAW + (size_t)m * DM; bf16* OUT = MIX + (size_t)m * DM;
#pragma unroll
        for (int grp = 0; grp < 3; ++grp) { const int h = 4 * grp + hq, ch0 = h * 64 + 4 * sub;
            float o[4], v0[4], g0[4], v1[4], g1[4], lrv[4] = {0.f, 0.f, 0.f, 0.f};
            unpk4(*(const v2u*)(O + ch0), o); unpk4(*(const v2u*)(P + C_RV + ch0), v0); unpk4(*(const v2u*)(P + C_RG + ch0), g0); unpk4(*(const v2u*)(Pp + C_RV + ch0), v1); unpk4(*(const v2u*)(Pp + C_RG + ch0), g1);
            const f32x4 muv = *(const f32x4*)(INF(I_MU_RKVG) + (l * 4 + 2) * 768 + ch0), mug = *(const f32x4*)(INF(I_MU_RKVG) + (l * 4 + 3) * 768 + ch0);
            const f32x4 lnw = *(const f32x4*)(INF(I_LNW) + l * 768 + ch0), lnb = *(const f32x4*)(INF(I_LNB) + l * 768 + ch0);
            f32x4 vf = {0.f, 0.f, 0.f, 0.f}, v0c = {0.f, 0.f, 0.f, 0.f};
            if (l > 0) { vf = *(const f32x4*)(VF + (size_t)m * 768 + ch0); v0c = *(const f32x4*)(INF(I_V0) + ch0); unpk4(*(const v2u*)(LR + (size_t)m * NLR + 1536 + ch0), lrv); }
            const float bn = BON[(size_t)m * 12 + h];
            float v[4], g[4], ssum = 0.f;
#pragma unroll
            for (int e = 0; e < 4; ++e) { v[e] = v0[e] + (hpf * v1[e] - v0[e]) * muv[e]; g[e] = g0[e] + (hpf * g1[e] - g0[e]) * mug[e];
                if (l > 0) v[e] = v[e] + (vf[e] - v[e]) * sigmoidf_(v0c[e] + lrv[e]);
                ssum += o[e]; }
            const float mean = red16(ssum) * (1.0f / 64.0f); float d[4], q = 0.f;
#pragma unroll
            for (int e = 0; e < 4; ++e) { d[e] = o[e] - mean; q += d[e] * d[e]; }
            const float rs = rsqrtf(red16(q) * (1.0f / 64.0f) + 64e-5f); float r[4];
#pragma unroll
            for (int e = 0; e < 4; ++e) r[e] = (d[e] * rs * lnw[e] + lnb[e] + bn * v[e]) * sigmoidf_(g[e]);
            v2u w; w.x = pk2h(r[0], r[1]); w.y = pk2h(r[2], r[3]); *(v2u*)(OUT + ch0) = w; }
        { const int h = hq, c0 = h * 128 + 8 * sub;
            float o[8], g[8]; unpk8(*(const v4u*)(O + 768 + c0), o); unpk8(*(const v4u*)(P + C_TG + c0), g);
            const f32x4 na = *(const f32x4*)(INF(I_RET_GN) + l * 512 + c0), nb = *(const f32x4*)(INF(I_RET_GN) + l * 512 + c0 + 4);
            float ssum = 0.f;
#pragma unroll
            for (int e = 0; e < 8; ++e) ssum += o[e];
            const float mean = red16(ssum) * (1.0f / 128.0f); float d[8], q = 0.f;
#pragma unroll
            for (int e = 0; e < 8; ++e) { d[e] = o[e] - mean; q += d[e] * d[e]; }
            const float rs = rsqrtf(red16(q) * (1.0f / 128.0f) + 1e-5f); float r[8];
#pragma unroll
            for (int e = 0; e < 8; ++e) r[e] = siluf_(g[e]) * d[e] * rs * (e < 4 ? na[e] : nb[e - 4]);
            v4u w; w.x = pk2h(r[0], r[1]); w.y = pk2h(r[2], r[3]); w.z = pk2h(r[4], r[5]); w.w = pk2h(r[6], r[7]); *(v4u*)(OUT + 768 + c0) = w; }
#pragma unroll
        for (int ps = 0; ps < 2; ++ps) { const int hr = 4 * ps + hq, h = hr < 6 ? hr : 5, c0 = h * 128 + 8 * sub;
            float o[8], z[8]; unpk8(*(const v4u*)(O + 1280 + c0), o); unpk8(*(const v4u*)(P + C_DZ + c0), z);
            const f32x4 na = *(const f32x4*)(INF(I_GDN_NW) + l * 768 + c0), nb = *(const f32x4*)(INF(I_GDN_NW) + l * 768 + c0 + 4);
            float q = 0.f;
#pragma unroll
            for (int e = 0; e < 8; ++e) q += o[e] * o[e];
            const float rs = rsqrtf(red16(q) * (1.0f / 128.0f) + 1e-6f); float r[8];
#pragma unroll
            for (int e = 0; e < 8; ++e) r[e] = o[e] * rs * (e < 4 ? na[e] : nb[e - 4]) * siluf_(z[e]);
            v4u w; w.x = pk2h(r[0], r[1]); w.y = pk2h(r[2], r[3]); w.z = pk2h(r[4], r[5]); w.w = pk2h(r[6], r[7]);
            if (hr < 6) *(v4u*)(OUT + 1280 + c0) = w; }
    }
}
#define XB_TMO      128
#define XB_XCNT(j)  (256  + 64 * (j))
#define XB_XSUB(j)  (1280 + 64 * (j))
#define XB_XGEN(j)  (2304 + 64 * (j))
#define XB_TOP      3328
#define XB_TOPGEN   3392
#define XCD_BAR_WORDS 3456
#define XB_SPIN_CAP (1u << 18)

__device__ __forceinline__ unsigned xb_ld(unsigned* p)              { return __hip_atomic_load(p, __ATOMIC_RELAXED, __HIP_MEMORY_SCOPE_AGENT); }
__device__ __forceinline__ unsigned xb_add(unsigned* p, unsigned v) { return __hip_atomic_fetch_add(p, v, __ATOMIC_RELAXED, __HIP_MEMORY_SCOPE_AGENT); }
__device__ __forceinline__ unsigned xb_xcc_id() { return (unsigned)__builtin_amdgcn_s_getreg((3 << 11) | 20) & 0xFu; }
#define XB_SPIN(cond, bar) do { unsigned _sp = 0; while (cond) { __builtin_amdgcn_s_sleep(1); \
    if ((++_sp & 255u) == 0u) { if (xb_ld(&(bar)[XB_TMO])) break; if (_sp > XB_SPIN_CAP) { atomicAdd(&(bar)[XB_TMO], 1u); break; } } } } while (0)

struct XcdBarrier {
    unsigned* bar; unsigned x;
    volatile LAS unsigned* st;
};

__device__ __forceinline__ XcdBarrier xcd_barrier_post(unsigned* bar, volatile LAS unsigned* st) {
    XcdBarrier b; b.bar = bar; b.x = xb_xcc_id(); b.st = st;
    if (otid() == 0) (void)xb_add(&bar[XB_XCNT(b.x)], 1u);
    return b;
}
__device__ __forceinline__ void xcd_barrier_complete(unsigned* bar, unsigned x, unsigned& nloc, unsigned& nx) {
    const unsigned G = gridDim.x * gridDim.y * gridDim.z;
    unsigned sum, cnt, mine, sp = 0u;
    for (;;) {
        sum = 0u; cnt = 0u; mine = 0u;
#pragma unroll
        for (unsigned j = 0; j < 16; ++j) { const unsigned c = xb_ld(&bar[XB_XCNT(j)]); sum += c; cnt += (c > 0u) ? 1u : 0u; mine = (j == x) ? c : mine; }
        if (sum == G) break;
        __builtin_amdgcn_s_sleep(1);
        if ((++sp & 255u) == 0u) { if (xb_ld(&bar[XB_TMO])) break; if (sp > XB_SPIN_CAP) { atomicAdd(&bar[XB_TMO], 1u); break; } }
    }
    nloc = mine > 0u ? mine : 1u; nx = cnt > 0u ? cnt : 1u;
}

__device__ __forceinline__ void xcd_barrier(const XcdBarrier& b) {
    asm volatile("s_waitcnt vmcnt(0)" ::: "memory");
    __syncthreads();
    if (otid() == 0) {
        unsigned* bar = b.bar;
        __builtin_amdgcn_s_waitcnt(0);
        unsigned nloc = b.st[0], nx = b.st[1];
        if (nloc == 0u) { xcd_barrier_complete(bar, b.x, nloc, nx); b.st[0] = nloc; b.st[1] = nx; }
        const unsigned old = xb_add(&bar[XB_XSUB(b.x)], 1u);
        const unsigned gen = old / nloc;
        if (old + 1u == (gen + 1u) * nloc) {
            __builtin_amdgcn_fence(__ATOMIC_RELEASE, "agent");
            asm volatile("s_waitcnt vmcnt(0)" ::: "memory");
            const unsigned og = xb_add(&bar[XB_TOP], 1u);
            const unsigned tg = og / nx;
            if (og + 1u == (tg + 1u) * nx) xb_add(&bar[XB_TOPGEN], 1u);
            else XB_SPIN(xb_ld(&bar[XB_TOPGEN]) == tg, bar);
            __builtin_amdgcn_fence(__ATOMIC_ACQUIRE, "agent");
            xb_add(&bar[XB_XGEN(b.x)], 1u);
            asm volatile("s_waitcnt vmcnt(0)" ::: "memory");
        } else {
            XB_SPIN(xb_ld(&bar[XB_XGEN(b.x)]) == gen, bar);
            __builtin_amdgcn_fence(__ATOMIC_ACQUIRE, "agent");
            asm volatile("s_waitcnt vmcnt(0)" ::: "memory");
        }
    }
    __syncthreads();
}

__device__ __forceinline__ void e1_tile(CArgs Ap, int l, int pm) {
    const bf16* PROJ = (const bf16*)(Ap->ws + WS_PROJ); bf16* __restrict__ A2 = (bf16*)(Ap->ws + WS_A2);
    const int tid = otid(), v = tid & 31, r0 = tid >> 5;
    int c1, c2; if (v < 12) { c1 = C_P1W + 8 * v; c2 = C_P2W + 8 * v; } else if (v < 24) { c1 = C_P1A + 8 * (v - 12); c2 = C_P2A + 8 * (v - 12); } else { c1 = C_P1V + 8 * (v - 24); c2 = C_P2V + 8 * (v - 24); }
    const bool is_w = v < 12, zero = (v >= 24) && (l == 0);
#pragma unroll
    for (int half = 0; half < 2; ++half) { v4u x1[8], x2[8];
#pragma unroll
        for (int k = 0; k < 8; ++k) { const int m = pm * 256 + r0 + 16 * (half * 8 + k); const bool hp = (m % SEQ) > 0;
            x1[k] = *(const v4u*)(PROJ + (size_t)m * NP + c1); x2[k] = *(const v4u*)(PROJ + (size_t)(hp ? m - 1 : m) * NP + c2); }
#pragma unroll
        for (int k = 0; k < 8; ++k) { const int m = pm * 256 + r0 + 16 * (half * 8 + k); const float hpf = ((m % SEQ) > 0) ? 1.f : 0.f;
            float a[8], b[8], o[8]; unpk8(x1[k], a); unpk8(x2[k], b);
#pragma unroll
            for (int e = 0; e < 8; ++e) { const float s = a[e] + hpf * b[e]; const float th = 1.0f - 2.0f * __builtin_amdgcn_rcpf(1.0f + __expf(2.0f * s)); o[e] = zero ? 0.f : (is_w ? th : s); }
            v4u w; w.x = pk2(o[0], o[1]); w.y = pk2(o[2], o[3]); w.z = pk2(o[4], o[5]); w.w = pk2(o[6], o[7]);
            *(v4u*)(A2 + (size_t)m * 256 + 8 * v) = w; } }
}

__global__ void __launch_bounds__(NTHR, 2) fwd_kernel(Args A_kernarg) {
    CArgs KA = (CArgs)__builtin_amdgcn_kernarg_segment_ptr();
    extern __shared__ __attribute__((aligned(16))) unsigned char lds_raw[];
    LAS unsigned char* lds0 = (LAS unsigned char*)lds_raw;
    const int tid = threadIdx.x;
    *(LAS int*)(size_t)tid_slot() = tid;
    if (tid < 4) ((LAS unsigned*)(lds0 + MISC_OFF))[tid] = 0u;
    __syncthreads();
#if !MK_SPLIT
    XcdBarrier bar = xcd_barrier_post((unsigned*)(KA->ws + WS_CTL) + CW_BAR, (volatile LAS unsigned*)(lds0 + MISC_OFF));
#define GRID_BAR() do { XcdBarrier b2_ = bar; asm volatile("" : "+s"(b2_.bar)); xcd_barrier(b2_); } while (0)
#else
#define GRID_BAR() do {} while (0)
#endif
#if MK_SPLIT
    const int lo = KA->ph_lo, hi = KA->ph_hi; int p = 0;
#define PH_IN (p >= lo && p < hi)
#define PH_NEXT (p + 1 < hi)
#define PH_INC ++p
#else
#define PH_IN true
#define PH_NEXT true
#define PH_INC do {} while (0)
#endif
#define PH_BEGIN if (PH_IN) { CArgs Ap = KA; asm volatile("" : "+s"(Ap)); unsigned char* ws = Ap->ws; LAS unsigned char* lds = lds0; \
        const int G = (int)gridDim.x, c = (int)blockIdx.x; LAS int* TOFF = (LAS int*)(lds + MISC_OFF + 64); (void)G; (void)c; (void)TOFF; (void)ws;
#define PH_END   if (PH_NEXT) { GRID_BAR(); } } PH_INC;
#define LAYER_BODY(l) \
        PH_BEGIN if (l == 0) { phase_convert<0>(Ap, 0, lds, c, G); phase_norm(Ap, 0, l); } else phase_norm(Ap, 1, l); __syncthreads(); PH_END \
        PH_BEGIN { pg8::Gemm g{(const bf16*)(ws + WS_H), (const bf16*)(ws + WS_WIN), NTOK, NP, DM}; unsigned* p1c = (unsigned*)(ws + WS_CTL) + CW_P1 + 64 * l; pg8::G1Order S{G, c, p1c}; \
            pg8::EpiBf16G1 E{(bf16*)(ws + WS_PROJ), NP}; \
            pg8::gemm_phase<pg8::EpiBf16G1, pg8::G1Order, true, true>(lds, g, S, E); \
            for (int uu = G - 1 - c; uu < 96; uu += G) {     \
                if (otid() == 0) { while (__hip_atomic_load(p1c, __ATOMIC_RELAXED, __HIP_MEMORY_SCOPE_AGENT) < 768u) __builtin_amdgcn_s_sleep(4); } \
                __syncthreads(); __builtin_amdgcn_fence(__ATOMIC_ACQUIRE, "agent"); \
                e1_tile(Ap, l, uu / 3); \
                asm volatile("s_waitcnt vmcnt(0)" ::: "memory"); __syncthreads(); __builtin_amdgcn_fence(__ATOMIC_ACQUIRE, "agent"); \
                int n3 = 3, k2 = 256; asm volatile("" : "+s"(n3), "+s"(k2)); pg8::Gemm g2{(const bf16*)(ws + WS_A2), (const bf16*)(ws + WS_LR2), NTOK, NLR, k2}; pg8::TriOrder S2{uu / 3, 3 * (uu % 3), n3}; \
                pg8::EpiBf16<0> E2{(bf16*)(ws + WS_LR), NLR, nullptr, 0, 0, 1.f}; \
                pg8::gemm_phase<pg8::EpiBf16<0>, pg8::TriOrder, true, PG8_SP2>(lds, g2, S2, E2); } } PH_END \
        PH_BEGIN phase_mixA(Ap, l, lds); PH_END \
        PH_BEGIN phase_mixB(Ap, l, lds); PH_END \
        PH_BEGIN phase_m2c(Ap, l); PH_END \
        PH_BEGIN { pg8::Gemm g{(const bf16*)(ws + WS_MIX), (const bf16*)(ws + WS_WOUT), NTOK, DM, DM}; pg8::StaticOrder S; S.init(NTOK, DM, G, c); \
            if (l == 0) { pg8::EpiResB16<true> E{(bf16*)(ws + WS_XBUF), Ap->in[I_X], DM}; pg8::gemm_phase<pg8::EpiResB16<true>, pg8::StaticOrder, true, true>(lds, g, S, E); } \
            else { pg8::EpiResB16<false> E{(bf16*)(ws + WS_XBUF), (const void*)(ws + WS_XBUF), DM}; pg8::gemm_phase<pg8::EpiResB16<false>, pg8::StaticOrder, true, true>(lds, g, S, E); } } PH_END \
        PH_BEGIN phase_convert<1>(Ap, l, lds, c, G); __syncthreads(); phase_r1(Ap, l, lds); PH_END \
        PH_BEGIN phase_r2(Ap, l, lds); PH_END \
        PH_BEGIN { compute_toff(Ap, l, lds, 0); \
            pg8::Gemm g{(const bf16*)(ws + WS_H), (const bf16*)(ws + WS_W13), MAXROWS, 512, DM}; pg8::GroupOrder<1> S{TOFF, G, c};     \
            pg8::EpiSwiGLU E{(bf16*)(ws + WS_HID), 256}; \
            pg8::gemm_phase_ga<pg8::EpiSwiGLU, pg8::GroupOrder<1>, true, true>(lds, g, S, E, (const int*)(ws + WS_ROWTOK)); \
            if (l == 0) {     \
                const int nun = 2 * __builtin_amdgcn_readfirstlane(TOFF[32]), nidle = G - nun; const bool split = nidle >= 32; \
                if (!split || c >= nun) { __syncthreads(); phase_convert<0>(Ap, 1, lds, split ? c - nun : c, split ? nidle : G); } } } PH_END \
        PH_BEGIN { compute_toff(Ap, l, lds, 0); \
            pg8::Gemm g{(const bf16*)(ws + WS_HID), (const bf16*)(ws + WS_W2X), MAXROWS, DM, 256}; pg8::GroupOrder<3> S{TOFF, G, c}; \
            pg8::EpiBf16Grp E{(bf16*)(ws + WS_YS), DM, 7}; \
            pg8::gemm_phase<pg8::EpiBf16Grp, pg8::GroupOrder<3>, true, PG8_SP2>(lds, g, S, E); } PH_END
    LAYER_BODY(0)
    LAYER_BODY(1)
    if (PH_IN) { CArgs Ap = KA; asm volatile("" : "+s"(Ap)); phase_norm(Ap, 2, 0); }
}
constexpr int NPHASES = 21;

extern "C" void kernel_launch(void* const* d_in, const int* in_sizes, int n_in, void* d_out, int out_size, void* d_ws, size_t ws_size, hipStream_t stream) {
    static int grid = 0;
    if (grid == 0) {
        if (n_in != 36 || out_size != NTOK * DM || ws_size < WS_END) { fprintf(stderr, "kernel_launch: unexpected shapes (n_in %d, out %d, ws %zu, need %zu)\n", n_in, out_size, ws_size, (size_t)WS_END); grid = -1; return; }
        int dev = 0, cus = 0, per_cu = 0;
        if (hipGetDevice(&dev) != hipSuccess || hipDeviceGetAttribute(&cus, hipDeviceAttributeMultiprocessorCount, dev) != hipSuccess) { grid = -1; return; }
        if (hipFuncSetAttribute((const void*)fwd_kernel, hipFuncAttributeMaxDynamicSharedMemorySize, LDS_BYTES) != hipSuccess) { fprintf(stderr, "kernel_launch: hipFuncSetAttribute failed\n"); grid = -1; return; }
        if (hipOccupancyMaxActiveBlocksPerMultiprocessor(&per_cu, (const void*)fwd_kernel, NTHR, LDS_BYTES) != hipSuccess || per_cu < 1) { fprintf(stderr, "kernel_launch: occupancy query says %d\n", per_cu); }
        (void)hipGetLastError();
        if (cus < 192) { fprintf(stderr, "kernel_launch: %d CUs (the gathered MoE up GEMM needs one unit per workgroup: >= 192)\n", cus); grid = -1; return; }
        grid = cus;
    }
    if (grid < 0) return;
    if (hipMemsetAsync((char*)d_ws + WS_CTL, 0, 32768, stream) != hipSuccess) return;
    Args a{};
    for (int i = 0; i < 36; ++i) a.in[i] = d_in[i];
    a.out = (float*)d_out; a.ws = (unsigned char*)d_ws;
#if MK_SPLIT
    for (int p = 0; p < NPHASES; ++p) { a.ph_lo = p; a.ph_hi = p + 1; hipLaunchKernelGGL(fwd_kernel, dim3(grid), dim3(NTHR), LDS_BYTES, stream, a); }
#else
    a.ph_lo = 0; a.ph_hi = NPHASES;
    hipLaunchKernelGGL(fwd_kernel, dim3(grid), dim3(NTHR), LDS_BYTES, stream, a);
#endif
}
```

```cpp
#include <hip/hip_runtime.h>
#include <cstdio>
#include <cstdint>
constexpr int TIDTAB_OFF = 147456;
__device__ __forceinline__ unsigned tid_slot() { const unsigned hw = (unsigned)__builtin_amdgcn_s_getreg((5 << 11) | 4) & 63u;
    unsigned ln; asm volatile("v_mbcnt_lo_u32_b32 %0, -1, 0\n\tv_mbcnt_hi_u32_b32 %0, -1, %0" : "=v"(ln));
    return TIDTAB_OFF + (hw * 64u + ln) * 4u; }
__device__ __forceinline__ int otid() { return *(const __attribute__((address_space(3))) int*)(size_t)tid_slot(); }
namespace pg8 {
#define PG8_LAS __attribute__((address_space(3)))
typedef unsigned short bf16_t;
typedef short bf16x8 __attribute__((ext_vector_type(8)));
typedef float f32x4 __attribute__((ext_vector_type(4)));
typedef unsigned u32x4 __attribute__((ext_vector_type(4)));
constexpr int BM = 256, BK = 64, HALF = 128, HTB = HALF * BK * 2  , STAGE_BYTES = 8 * HTB, NXCD = 8, WGM = 8;

__host__ __device__ __forceinline__ int lds_byte(int r, int c) { const int st = (r >> 4) * 2 + (c >> 5), rr = r & 15, cc = c & 31, ob = rr * 64 + cc * 2; return st * 1024 + (ob ^ (((ob >> 9) & 1) << 5)); }
__host__ __device__ __forceinline__ void stage_rc(int b, int& R, int& C) { const int st = b / 1024, sb = b % 1024, swz = sb ^ (((sb >> 9) & 1) << 5); R = (st >> 1) * 16 + swz / 64; C = (st & 1) * 32 + (swz % 64) / 2; }
__host__ __device__ __forceinline__ int perm32(int rho) { const int n = rho >> 4, i = rho & 15; return 8 * (i >> 2) + 4 * n + (i & 3); }

struct Unit { int pm, pn; };
struct Gemm { const bf16_t* A; const bf16_t* Bt; int M, N, K; };

struct StaticOrder {
    int nM, nN, nwg, G, c;
    __host__ __device__ void init(int M, int N, int G_, int c_) { nM = M / BM; nN = N / BM; nwg = nM * nN; G = G_; c = c_; }
    __host__ __device__ bool next(int i, Unit& u) const {
        const long L = (long)i * G + c; if (L >= nwg) return false;
        int wgid = (int)L; { const int q = nwg / NXCD, r = nwg % NXCD, xcd = wgid % NXCD, off = wgid / NXCD; wgid = (xcd < r ? xcd * (q + 1) : r * (q + 1) + (xcd - r) * q) + off; }
        const int nig = WGM * nN, gid = wgid / nig, fm = gid * WGM, gsz = (nM - fm) < WGM ? (nM - fm) : WGM;
        u.pm = fm + ((wgid % nig) % gsz); u.pn = (wgid % nig) / gsz; return true;
    }
    __device__ __forceinline__ void a_ready(const Unit&) const {}
    __device__ __forceinline__ void done(const Unit&) const {}
};

__device__ __forceinline__ unsigned cvt_pk_bf16(float lo, float hi) { unsigned r; asm volatile("v_cvt_pk_bf16_f32 %0, %1, %2" : "=v"(r) : "v"(lo), "v"(hi)); return r; }
typedef float f32x2 __attribute__((ext_vector_type(2)));
__device__ __forceinline__ f32x2 gelu_pk(f32x2 v) {
    const f32x2 av = __builtin_elementwise_abs(v), d = av * 0.2316418882f + 1.0f;
    f32x2 t; t.x = __builtin_amdgcn_rcpf(d.x); t.y = __builtin_amdgcn_rcpf(d.y);
    f32x2 q = t * 0.5307027145f + (-0.7265760135f); q = q * t + 0.7107068705f; q = q * t + (-0.142248368f); q = q * t + 0.127414796f; q = q * t;
    const f32x2 s = (v * v) * (-0.72134752044f);
    f32x2 e; e.x = __builtin_amdgcn_exp2f(s.x); e.y = __builtin_amdgcn_exp2f(s.y);
    const f32x2 m = v * (q * e), r = v - m;
    f32x2 o; o.x = v.x < 0.f ? m.x : r.x; o.y = v.y < 0.f ? m.y : r.y; return o;
}

template <int ACT  > struct EpiBf16 {
    static constexpr bool PERM = true, AFTER_DRAIN = false; static_assert(ACT == 0 || ACT == 1, "EpiBf16: ACT is 0 (none) or 1 (gelu_pk)");
    bf16_t* O; int ldc; const float* bias; int split_cols; size_t split_stride; float scale0;
    __device__ __forceinline__ void operator()(const f32x4 (&acc)[2][2][4][2], const Unit& u, int wr, int wc, int fr, int fq) const {
        const int row0 = u.pm * BM + wr * 64 + fr; int colt = u.pn * BM; bf16_t* base = O;
        float sc = 1.f; if (split_cols) { const int t = colt / split_cols; base += (size_t)t * split_stride; colt -= t * split_cols; if (t == 0) sc = scale0; }
        const int col0 = colt + wc * 32 + 8 * fq, bcol0 = u.pn * BM + wc * 32 + 8 * fq;
        f32x4 bv[2][2];
#pragma unroll
        for (int bj = 0; bj < 2; ++bj)
#pragma unroll
            for (int n = 0; n < 2; ++n) bv[bj][n] = bias ? *(const f32x4*)(bias + bcol0 + bj * HALF + 4 * n) : (f32x4){0.f, 0.f, 0.f, 0.f};
#pragma unroll
        for (int ai = 0; ai < 2; ++ai)
#pragma unroll
            for (int m = 0; m < 4; ++m) { bf16_t* rowp = base + (size_t)(row0 + ai * HALF + m * 16) * ldc + col0;
#pragma unroll
                for (int bj = 0; bj < 2; ++bj) { f32x4 v0 = acc[ai][bj][m][0] + bv[bj][0], v1 = acc[ai][bj][m][1] + bv[bj][1];
                    if (ACT == 1) { f32x2 a = gelu_pk((f32x2){v0[0], v0[1]}), b = gelu_pk((f32x2){v0[2], v0[3]}), c = gelu_pk((f32x2){v1[0], v1[1]}), d = gelu_pk((f32x2){v1[2], v1[3]});
                        v0 = (f32x4){a.x, a.y, b.x, b.y}; v1 = (f32x4){c.x, c.y, d.x, d.y}; }
                    v0 = v0 * sc; v1 = v1 * sc; u32x4 w; w.x = cvt_pk_bf16(v0[0], v0[1]); w.y = cvt_pk_bf16(v0[2], v0[3]); w.z = cvt_pk_bf16(v1[0], v1[1]); w.w = cvt_pk_bf16(v1[2], v1[3]);
                    *(u32x4*)(rowp + bj * HALF) = w; } }
    }
};

struct EpiResF32 {
    static constexpr bool PERM = false, AFTER_DRAIN = false;
    float* C; const float* R; int ldc;
    __device__ __forceinline__ void operator()(const f32x4 (&acc)[2][2][4][2], const Unit& u, int wr, int wc, int fr, int fq) const {
        const int row0 = u.pm * BM + wr * 64 + fr, col0 = u.pn * BM + wc * 32 + 4 * fq;
#pragma unroll
        for (int ai = 0; ai < 2; ++ai) {
            f32x4 rv[4][2][2];
#pragma unroll
            for (int m = 0; m < 4; ++m) { const size_t ro = (size_t)(row0 + ai * HALF + m * 16) * ldc + col0;
#pragma unroll
                for (int bj = 0; bj < 2; ++bj)
#pragma unroll
                    for (int n = 0; n < 2; ++n) rv[m][bj][n] = *(const f32x4*)(R + ro + bj * HALF + n * 16); }
            asm volatile("s_waitcnt vmcnt(0)" ::: "memory");
#pragma unroll
            for (int m = 0; m < 4; ++m) { const size_t ro = (size_t)(row0 + ai * HALF + m * 16) * ldc + col0;
#pragma unroll
                for (int bj = 0; bj < 2; ++bj)
#pragma unroll
                    for (int n = 0; n < 2; ++n) *(f32x4*)(C + ro + bj * HALF + n * 16) = rv[m][bj][n] + acc[ai][bj][m][n]; } }
    }
};
struct EpiSwiGLU {
    static constexpr bool PERM = true, AFTER_DRAIN = false;
    bf16_t* O; int ldc;
    __device__ __forceinline__ float act(float g, float up) const { return g * up * __builtin_amdgcn_rcpf(1.0f + __expf(-g)); }
    __device__ __forceinline__ void operator()(const f32x4 (&acc)[2][2][4][2], const Unit& u, int wr, int wc, int fr, int fq) const {
        const int row0 = u.pm * BM + wr * 64 + fr, col0 = (u.pn & 1) * HALF + wc * 32 + 8 * fq;
#pragma unroll
        for (int ai = 0; ai < 2; ++ai)
#pragma unroll
            for (int m = 0; m < 4; ++m) { bf16_t* rowp = O + (size_t)(row0 + ai * HALF + m * 16) * ldc + col0;
                const f32x4 g0 = acc[ai][0][m][0], g1 = acc[ai][0][m][1], u0 = acc[ai][1][m][0], u1 = acc[ai][1][m][1];
                u32x4 w; w.x = cvt_pk_bf16(act(g0[0], u0[0]), act(g0[1], u0[1])); w.y = cvt_pk_bf16(act(g0[2], u0[2]), act(g0[3], u0[3]));
                w.z = cvt_pk_bf16(act(g1[0], u1[0]), act(g1[1], u1[1])); w.w = cvt_pk_bf16(act(g1[2], u1[2]), act(g1[3], u1[3]));
                *(u32x4*)rowp = w; }
    }
};
struct EpiBf16Grp {
    static constexpr bool PERM = true, AFTER_DRAIN = false;
    bf16_t* O; int ldc, ntn_mask;
    __device__ __forceinline__ void operator()(const f32x4 (&acc)[2][2][4][2], const Unit& u, int wr, int wc, int fr, int fq) const {
        const int row0 = u.pm * BM + wr * 64 + fr, col0 = (u.pn & ntn_mask) * BM + wc * 32 + 8 * fq;
#pragma unroll
        for (int ai = 0; ai < 2; ++ai)
#pragma unroll
            for (int m = 0; m < 4; ++m) { bf16_t* rowp = O + (size_t)(row0 + ai * HALF + m * 16) * ldc + col0;
#pragma unroll
                for (int bj = 0; bj < 2; ++bj) { const f32x4 v0 = acc[ai][bj][m][0], v1 = acc[ai][bj][m][1];
                    u32x4 w; w.x = cvt_pk_bf16(v0[0], v0[1]); w.y = cvt_pk_bf16(v0[2], v0[3]); w.z = cvt_pk_bf16(v1[0], v1[1]); w.w = cvt_pk_bf16(v1[2], v1[3]);
                    *(u32x4*)(rowp + bj * HALF) = w; } }
    }
};
template <int LOGN> struct GroupOrder {
    const PG8_LAS int* toff; int G, c;
    __device__ __forceinline__ bool next(int i, Unit& u) const {
        const int ntiles = __builtin_amdgcn_readfirstlane(toff[32]);
        const int L = i * G + c; if (L >= (ntiles << LOGN)) return false;
        const int pm = L >> LOGN, pl = L & ((1 << LOGN) - 1); const int e = __builtin_amdgcn_readfirstlane(toff[80 + pm]);
        u.pm = pm; u.pn = (e << LOGN) + pl; return true;
    }
    __device__ __forceinline__ void a_ready(const Unit&) const {}
    __device__ __forceinline__ void done(const Unit&) const {}
};
struct G1Order {
    int G, c; unsigned* cnt;
    __device__ __forceinline__ bool next(int i, Unit& u) const {
        const int L = i * G + c; if (L >= 1120) return false;
        if (L < 96) { u.pm = L / 3; u.pn = 32 + L % 3; return true; }
        int wgid = L - 96; { const int q = 1024 / NXCD, xcd = wgid % NXCD, off = wgid / NXCD; wgid = xcd * q + off; }
        const int nig = WGM * 32, gid = wgid / nig, fm = gid * WGM;
        u.pm = fm + ((wgid % nig) % WGM); u.pn = (wgid % nig) / WGM; return true;
    }
    __device__ __forceinline__ void a_ready(const Unit&) const {}
    __device__ __forceinline__ void done(const Unit& u) const {
        if (u.pn >= 32) {
            asm volatile("s_waitcnt vmcnt(0)" ::: "memory"); __builtin_amdgcn_s_barrier();
            if (otid() == 0) { __builtin_amdgcn_fence(__ATOMIC_RELEASE, "agent"); asm volatile("s_waitcnt vmcnt(0)" ::: "memory"); __hip_atomic_fetch_add(cnt, 8u, __ATOMIC_RELAXED, __HIP_MEMORY_SCOPE_AGENT); } }
    }
};
struct TriOrder {
    int pm, pn0, n;
    __device__ __forceinline__ bool next(int i, Unit& u) const { if (i >= n) return false; u.pm = pm; u.pn = pn0 + i; return true; }
    __device__ __forceinline__ void a_ready(const Unit&) const {}
    __device__ __forceinline__ void done(const Unit&) const {}
};
#ifndef G1_ALL_WT
#define G1_ALL_WT 0
#define G1_EARLY_WT 0
#endif
struct EpiBf16G1 {
    static constexpr bool PERM = true, AFTER_DRAIN = false;
    bf16_t* O; int ldc;
    __device__ __forceinline__ void operator()(const f32x4 (&acc)[2][2][4][2], const Unit& u, int wr, int wc, int fr, int fq) const {
        const int row0 = u.pm * BM + wr * 64 + fr, col0 = u.pn * BM + wc * 32 + 8 * fq;
        if ((G1_EARLY_WT && u.pn >= 32) || G1_ALL_WT) {
#pragma unroll
            for (int ai = 0; ai < 2; ++ai)
#pragma unroll
                for (int m = 0; m < 4; ++m) { bf16_t* rowp = O + (size_t)(row0 + ai * HALF + m * 16) * ldc + col0;
#pragma unroll
                    for (int bj = 0; bj < 2; ++bj) { const f32x4 v0 = acc[ai][bj][m][0], v1 = acc[ai][bj][m][1];
                        u32x4 w; w.x = cvt_pk_bf16(v0[0], v0[1]); w.y = cvt_pk_bf16(v0[2], v0[3]); w.z = cvt_pk_bf16(v1[0], v1[1]); w.w = cvt_pk_bf16(v1[2], v1[3]);
                        asm volatile("global_store_dwordx4 %0, %1, off sc1\n\ts_nop 1" :: "v"(rowp + bj * HALF), "v"(w) : "memory"); } }
        } else {
#pragma unroll
            for (int ai = 0; ai < 2; ++ai)
#pragma unroll
                for (int m = 0; m < 4; ++m) { bf16_t* rowp = O + (size_t)(row0 + ai * HALF + m * 16) * ldc + col0;
#pragma unroll
                    for (int bj = 0; bj < 2; ++bj) { const f32x4 v0 = acc[ai][bj][m][0], v1 = acc[ai][bj][m][1];
                        u32x4 w; w.x = cvt_pk_bf16(v0[0], v0[1]); w.y = cvt_pk_bf16(v0[2], v0[3]); w.z = cvt_pk_bf16(v1[0], v1[1]); w.w = cvt_pk_bf16(v1[2], v1[3]);
                        *(u32x4*)(rowp + bj * HALF) = w; } }
        }
    }
};
template <bool RF32> struct EpiResB16 {
    static constexpr bool PERM = true, AFTER_DRAIN = false;
    bf16_t* C; const void* R; int ldc;
    __device__ __forceinline__ void operator()(const f32x4 (&acc)[2][2][4][2], const Unit& u, int wr, int wc, int fr, int fq) const {
        const int row0 = u.pm * BM + wr * 64 + fr, col0 = u.pn * BM + wc * 32 + 8 * fq;
#pragma unroll
        for (int ai = 0; ai < 2; ++ai) {
            f32x4 rf[4][2][2]; u32x4 rb[4][2];
#pragma unroll
            for (int m = 0; m < 4; ++m) { const size_t ro = (size_t)(row0 + ai * HALF + m * 16) * ldc + col0;
#pragma unroll
                for (int bj = 0; bj < 2; ++bj) {
                    if (RF32) { rf[m][bj][0] = *(const f32x4*)((const float*)R + ro + bj * HALF); rf[m][bj][1] = *(const f32x4*)((const float*)R + ro + bj * HALF + 4); }
                    else rb[m][bj] = *(const u32x4*)((const bf16_t*)R + ro + bj * HALF); } }
            asm volatile("s_waitcnt vmcnt(0)" ::: "memory");
#pragma unroll
            for (int m = 0; m < 4; ++m) { const size_t ro = (size_t)(row0 + ai * HALF + m * 16) * ldc + col0;
#pragma unroll
                for (int bj = 0; bj < 2; ++bj) { f32x4 v0 = acc[ai][bj][m][0], v1 = acc[ai][bj][m][1];
                    if (RF32) { v0 += rf[m][bj][0]; v1 += rf[m][bj][1]; }
                    else { const u32x4 r = rb[m][bj];
                        v0 += (f32x4){__builtin_bit_cast(float, r.x << 16), __builtin_bit_cast(float, r.x & 0xffff0000u), __builtin_bit_cast(float, r.y << 16), __builtin_bit_cast(float, r.y & 0xffff0000u)};
                        v1 += (f32x4){__builtin_bit_cast(float, r.z << 16), __builtin_bit_cast(float, r.z & 0xffff0000u), __builtin_bit_cast(float, r.w << 16), __builtin_bit_cast(float, r.w & 0xffff0000u)}; }
                    u32x4 w; w.x = cvt_pk_bf16(v0[0], v0[1]); w.y = cvt_pk_bf16(v0[2], v0[3]); w.z = cvt_pk_bf16(v1[0], v1[1]); w.w = cvt_pk_bf16(v1[2], v1[3]);
                    *(u32x4*)(C + ro + bj * HALF) = w; } } }
    }
};
template <class Epi, class Sched, bool ALIGN_EPI = false, bool SP2 = false>
__device__ __forceinline__ void gemm_phase(PG8_LAS unsigned char* lds, const Gemm g, const Sched& S, const Epi& E) {
    const int tid = otid(), wid = __builtin_amdgcn_readfirstlane(tid >> 6), lane = tid & 63, wr = wid >> 2, wc = wid & 3, fr = lane & 15, fq = lane >> 4;
    const int K = g.K, nt = K / BK;
    unsigned voffA[2], voffB[2];
#pragma unroll
    for (int i = 0; i < 2; ++i) { int R, C; stage_rc(tid * 16 + i * 8192, R, C); const int Rb = Epi::PERM ? ((R & ~31) + perm32(R & 31)) : R;
        voffA[i] = (unsigned)(R * K + C) * 2u; voffB[i] = (unsigned)(Rb * K + C) * 2u; }
    const size_t kstep = (size_t)(BK * 2);
    const size_t hstep = (size_t)HALF * K * 2;
    const size_t tstep = 2 * hstep;
    const unsigned ldsw = (unsigned)wid * 1024u;
    const int aoff = lds_byte(wr * 64 + fr, fq * 8), boff = lds_byte(wc * 32 + fr, fq * 8);
#define PG8_SA(b, h) (((b) * 2 + (h)) * HTB)
#define PG8_SB(b, h) ((4 + (b) * 2 + (h)) * HTB)
#define PG8_STAGE(bufoff, gbase, voff) do { _Pragma("unroll") for (int _i = 0; _i < 2; ++_i) \
        __builtin_amdgcn_global_load_lds((const unsigned*)((const char*)(gbase) + (voff)[_i]), (PG8_LAS unsigned*)(lds + (bufoff) + ldsw + _i * 8192), 16, 0, 0); } while (0)
#define PG8_LDA(dst, b, h) do { _Pragma("unroll") for (int m = 0; m < 4; ++m) _Pragma("unroll") for (int k = 0; k < 2; ++k) dst[m][k] = *(const PG8_LAS bf16x8*)(lds + PG8_SA(b, h) + aoff + m * 2048 + k * 1024); } while (0)
#define PG8_LDB(dst, b, h) do { _Pragma("unroll") for (int n = 0; n < 2; ++n) _Pragma("unroll") for (int k = 0; k < 2; ++k) dst[n][k] = *(const PG8_LAS bf16x8*)(lds + PG8_SB(b, h) + boff + n * 2048 + k * 1024); } while (0)
#define PG8_MMA(ai, bj, At, Bt) do { __builtin_amdgcn_s_setprio(1); _Pragma("unroll") for (int m = 0; m < 4; ++m) _Pragma("unroll") for (int n = 0; n < 2; ++n) _Pragma("unroll") for (int k = 0; k < 2; ++k) \
        acc[ai][bj][m][n] = __builtin_amdgcn_mfma_f32_16x16x32_bf16(Bt[n][k], At[m][k], acc[ai][bj][m][n], 0, 0, 0); __builtin_amdgcn_s_setprio(0); } while (0)
#define PG8_WAIT_V(n) asm volatile("s_waitcnt vmcnt(" #n ")" ::: "memory")
#define PG8_WAIT_L(n) asm volatile("s_waitcnt lgkmcnt(" #n ")" ::: "memory")
#define PG8_BAR __builtin_amdgcn_s_barrier()
#define PG8_SCHED __builtin_amdgcn_sched_barrier(0)
    Unit cur, nxt; int ui = 0;
    if (!S.next(0, cur)) return;
    f32x4 acc[2][2][4][2];
#pragma unroll
    for (int a = 0; a < 2; ++a)
#pragma unroll
        for (int b = 0; b < 2; ++b)
#pragma unroll
            for (int m = 0; m < 4; ++m)
#pragma unroll
                for (int n = 0; n < 2; ++n) acc[a][b][m][n] = (f32x4){0.f, 0.f, 0.f, 0.f};
    bf16x8 At[4][2], B0[2][2], B1[2][2];
    const char* cA = (const char*)g.A + (size_t)cur.pm * tstep; const char* cB = (const char*)g.Bt + (size_t)cur.pn * tstep;
    S.a_ready(cur);
    if constexpr (SP2) {
        PG8_STAGE(PG8_SB(0, 0), cB, voffB); PG8_STAGE(PG8_SB(0, 1), cB + hstep, voffB); PG8_STAGE(PG8_SA(0, 0), cA, voffA); PG8_STAGE(PG8_SA(0, 1), cA + hstep, voffA);
        if (wr == 1) PG8_BAR;
        PG8_WAIT_V(2); PG8_BAR;
        PG8_STAGE(PG8_SB(1, 0), cB + kstep, voffB); PG8_STAGE(PG8_SA(1, 0), cA + kstep, voffA); PG8_STAGE(PG8_SB(1, 1), cB + hstep + kstep, voffB);
        PG8_WAIT_V(6); PG8_BAR;
    } else {
        PG8_STAGE(PG8_SB(0, 0), cB, voffB); PG8_STAGE(PG8_SA(0, 0), cA, voffA); PG8_STAGE(PG8_SB(0, 1), cB + hstep, voffB); PG8_STAGE(PG8_SA(0, 1), cA + hstep, voffA);
        if (wr == 1) PG8_BAR;
        PG8_WAIT_V(4); PG8_BAR;
        PG8_STAGE(PG8_SB(1, 0), cB + kstep, voffB); PG8_STAGE(PG8_SA(1, 0), cA + kstep, voffA); PG8_STAGE(PG8_SB(1, 1), cB + hstep + kstep, voffB);
        PG8_WAIT_V(6); PG8_BAR;
    }
    for (;;) {
        const bool has_next = S.next(ui + 1, nxt);
        const char* nA = has_next ? (const char*)g.A + (size_t)nxt.pm * tstep : cA; const char* nB = has_next ? (const char*)g.Bt + (size_t)nxt.pn * tstep : cB;
        for (int t = 0; t < nt; t += 2) {
            const bool last = (t == nt - 2);
            const char* a1 = cA + (size_t)(t + 1) * kstep;
            const char* a2 = last ? nA : cA + (size_t)(t + 2) * kstep; const char* b2 = last ? nB : cB + (size_t)(t + 2) * kstep;
            const char* a3 = a2 + kstep; const char* b3 = b2 + kstep;
            if (last && has_next) S.a_ready(nxt);
            if constexpr (SP2) {
            PG8_LDB(B0, 0, 0); PG8_LDB(B1, 0, 1); PG8_SCHED; PG8_LDA(At, 0, 0); PG8_STAGE(PG8_SA(1, 1), a1 + hstep, voffA);
            PG8_WAIT_V(8); PG8_WAIT_L(0); PG8_BAR; PG8_MMA(0, 0, At, B0); PG8_MMA(0, 1, At, B1); PG8_BAR; PG8_SCHED;
            PG8_LDA(At, 0, 1); PG8_STAGE(PG8_SB(0, 0), b2, voffB); PG8_STAGE(PG8_SB(0, 1), b2 + hstep, voffB); PG8_STAGE(PG8_SA(0, 0), a2, voffA);
            PG8_WAIT_V(8); PG8_WAIT_L(0); PG8_BAR; PG8_MMA(1, 0, At, B0); PG8_MMA(1, 1, At, B1); PG8_BAR; PG8_SCHED;
            PG8_LDB(B0, 1, 0); PG8_LDB(B1, 1, 1); PG8_SCHED; PG8_LDA(At, 1, 0); PG8_STAGE(PG8_SA(0, 1), a2 + hstep, voffA);
            PG8_WAIT_V(8); PG8_WAIT_L(0); PG8_BAR; PG8_MMA(0, 0, At, B0); PG8_MMA(0, 1, At, B1); PG8_BAR; PG8_SCHED;
            PG8_LDA(At, 1, 1); PG8_STAGE(PG8_SB(1, 0), b3, voffB); PG8_STAGE(PG8_SB(1, 1), b3 + hstep, voffB); PG8_STAGE(PG8_SA(1, 0), a3, voffA);
            PG8_WAIT_V(8); PG8_WAIT_L(0); PG8_BAR; PG8_MMA(1, 0, At, B0); PG8_MMA(1, 1, At, B1); PG8_BAR; PG8_SCHED;
            } else {
            PG8_LDB(B0, 0, 0); PG8_SCHED; PG8_LDA(At, 0, 0); PG8_STAGE(PG8_SA(1, 1), a1 + hstep, voffA);
            PG8_WAIT_L(8); PG8_BAR; PG8_WAIT_L(0); PG8_MMA(0, 0, At, B0); PG8_BAR; PG8_SCHED;
            PG8_LDB(B1, 0, 1); PG8_STAGE(PG8_SB(0, 0), b2, voffB);
            PG8_BAR; PG8_WAIT_L(0); PG8_MMA(0, 1, At, B1); PG8_BAR;
            PG8_LDA(At, 0, 1); PG8_STAGE(PG8_SA(0, 0), a2, voffA);
            PG8_BAR; PG8_WAIT_L(0); PG8_MMA(1, 0, At, B0); PG8_BAR; PG8_SCHED;
            PG8_STAGE(PG8_SB(0, 1), b2 + hstep, voffB);
            PG8_WAIT_V(6); PG8_BAR; PG8_MMA(1, 1, At, B1); PG8_BAR;
            PG8_LDB(B0, 1, 0); PG8_SCHED; PG8_LDA(At, 1, 0); PG8_STAGE(PG8_SA(0, 1), a2 + hstep, voffA);
            PG8_WAIT_L(8); PG8_BAR; PG8_WAIT_L(0); PG8_MMA(0, 0, At, B0); PG8_BAR; PG8_SCHED;
            PG8_LDB(B1, 1, 1); PG8_STAGE(PG8_SB(1, 0), b3, voffB);
            PG8_BAR; PG8_WAIT_L(0); PG8_MMA(0, 1, At, B1); PG8_BAR;
            PG8_LDA(At, 1, 1); PG8_STAGE(PG8_SA(1, 0), a3, voffA);
            PG8_BAR; PG8_WAIT_L(0); PG8_MMA(1, 0, At, B0); PG8_BAR; PG8_SCHED;
            PG8_STAGE(PG8_SB(1, 1), b3 + hstep, voffB);
            PG8_WAIT_V(6); PG8_BAR; PG8_MMA(1, 1, At, B1); PG8_BAR;
            }
        }
        if constexpr (ALIGN_EPI) { if (wr == 0) PG8_BAR; }
        if constexpr (!Epi::AFTER_DRAIN) { E(acc, cur, wr, wc, fr, fq); S.done(cur); }
        if (!has_next) break;
#pragma unroll
        for (int a = 0; a < 2; ++a)
#pragma unroll
            for (int b = 0; b < 2; ++b)
#pragma unroll
                for (int m = 0; m < 4; ++m)
#pragma unroll
                    for (int n = 0; n < 2; ++n) acc[a][b][m][n] = (f32x4){0.f, 0.f, 0.f, 0.f};
        cur = nxt; cA = nA; cB = nB; ++ui;
        if constexpr (ALIGN_EPI) { if (wr == 1) PG8_BAR; }
    }
    PG8_WAIT_V(0);
    if constexpr (!ALIGN_EPI) { if (wr == 0) PG8_BAR; }
    PG8_BAR;
    if constexpr (Epi::AFTER_DRAIN) { E.fused(acc, cur, wr, wc, fr, fq, lds, wid, lane); S.done(cur); }
#undef PG8_SA
#undef PG8_SB
#undef PG8_STAGE
#undef PG8_LDA
#undef PG8_LDB
#undef PG8_MMA
#undef PG8_WAIT_V
#undef PG8_WAIT_L
#undef PG8_BAR
#undef PG8_SCHED
}
template <class Epi, class Sched, bool ALIGN_EPI = false, bool SP2 = false>
__device__ __forceinline__ void gemm_phase_ga(PG8_LAS unsigned char* lds, const Gemm g, const Sched& S, const Epi& E, const PG8_LAS int* rowtok) {
    const int tid = otid(), wid = __builtin_amdgcn_readfirstlane(tid >> 6), lane = tid & 63, wr = wid >> 2, wc = wid & 3, fr = lane & 15, fq = lane >> 4;
    const int K = g.K, nt = K / BK;
    unsigned voffA[2], voffB[2];
#pragma unroll
    for (int i = 0; i < 2; ++i) { int R, C; stage_rc(tid * 16 + i * 8192, R, C); const int Rb = Epi::PERM ? ((R & ~31) + perm32(R & 31)) : R;
        voffA[i] = (unsigned)(R * K + C) * 2u; voffB[i] = (unsigned)(Rb * K + C) * 2u; }
    const size_t kstep = (size_t)(BK * 2);
    const size_t hstep = (size_t)HALF * K * 2;
    const size_t tstep = 2 * hstep;
    const unsigned ldsw = (unsigned)wid * 1024u;
    const int aoff = lds_byte(wr * 64 + fr, fq * 8), boff = lds_byte(wc * 32 + fr, fq * 8);
#define PG8_SA(b, h) (((b) * 2 + (h)) * HTB)
#define PG8_SB(b, h) ((4 + (b) * 2 + (h)) * HTB)
#define PG8_STAGE(bufoff, gbase, voff) do { _Pragma("unroll") for (int _i = 0; _i < 2; ++_i) \
        __builtin_amdgcn_global_load_lds((const unsigned*)((const char*)(gbase) + (voff)[_i]), (PG8_LAS unsigned*)(lds + (bufoff) + ldsw + _i * 8192), 16, 0, 0); } while (0)
#define PG8_LDA(dst, b, h) do { _Pragma("unroll") for (int m = 0; m < 4; ++m) _Pragma("unroll") for (int k = 0; k < 2; ++k) dst[m][k] = *(const PG8_LAS bf16x8*)(lds + PG8_SA(b, h) + aoff + m * 2048 + k * 1024); } while (0)
#define PG8_LDB(dst, b, h) do { _Pragma("unroll") for (int n = 0; n < 2; ++n) _Pragma("unroll") for (int k = 0; k < 2; ++k) dst[n][k] = *(const PG8_LAS bf16x8*)(lds + PG8_SB(b, h) + boff + n * 2048 + k * 1024); } while (0)
#define PG8_MMA(ai, bj, At, Bt) do { __builtin_amdgcn_s_setprio(1); _Pragma("unroll") for (int m = 0; m < 4; ++m) _Pragma("unroll") for (int n = 0; n < 2; ++n) _Pragma("unroll") for (int k = 0; k < 2; ++k) \
        acc[ai][bj][m][n] = __builtin_amdgcn_mfma_f32_16x16x32_bf16(Bt[n][k], At[m][k], acc[ai][bj][m][n], 0, 0, 0); __builtin_amdgcn_s_setprio(0); } while (0)
#define PG8_WAIT_V(n) asm volatile("s_waitcnt vmcnt(" #n ")" ::: "memory")
#define PG8_WAIT_L(n) asm volatile("s_waitcnt lgkmcnt(" #n ")" ::: "memory")
#define PG8_BAR __builtin_amdgcn_s_barrier()
#define PG8_SCHED __builtin_amdgcn_sched_barrier(0)
    Unit cur, nxt; int ui = 0;
    if (!S.next(0, cur)) return;
    f32x4 acc[2][2][4][2];
#pragma unroll
    for (int a = 0; a < 2; ++a)
#pragma unroll
        for (int b = 0; b < 2; ++b)
#pragma unroll
            for (int m = 0; m < 4; ++m)
#pragma unroll
                for (int n = 0; n < 2; ++n) acc[a][b][m][n] = (f32x4){0.f, 0.f, 0.f, 0.f};
    bf16x8 At[4][2], B0[2][2], B1[2][2];
    unsigned voffA0[2], voffA1[2];
#pragma unroll
    for (int i = 0; i < 2; ++i) { int R, C; stage_rc(tid * 16 + i * 8192, R, C); const PG8_LAS int* rt = rowtok;
        voffA0[i] = (unsigned)(rt[R] * K + C) * 2u; voffA1[i] = (unsigned)(rt[HALF + R] * K + C) * 2u; }
    const char* cA = (const char*)g.A; const char* cB = (const char*)g.Bt + (size_t)cur.pn * tstep;
    S.a_ready(cur);
    if constexpr (SP2) {
        PG8_STAGE(PG8_SB(0, 0), cB, voffB); PG8_STAGE(PG8_SB(0, 1), cB + hstep, voffB); PG8_STAGE(PG8_SA(0, 0), cA, voffA0); PG8_STAGE(PG8_SA(0, 1), cA, voffA1);
        if (wr == 1) PG8_BAR;
        PG8_WAIT_V(2); PG8_BAR;
        PG8_STAGE(PG8_SB(1, 0), cB + kstep, voffB); PG8_STAGE(PG8_SA(1, 0), cA + kstep, voffA0); PG8_STAGE(PG8_SB(1, 1), cB + hstep + kstep, voffB);
        PG8_WAIT_V(6); PG8_BAR;
    } else {
        PG8_STAGE(PG8_SB(0, 0), cB, voffB); PG8_STAGE(PG8_SA(0, 0), cA, voffA0); PG8_STAGE(PG8_SB(0, 1), cB + hstep, voffB); PG8_STAGE(PG8_SA(0, 1), cA, voffA1);
        if (wr == 1) PG8_BAR;
        PG8_WAIT_V(4); PG8_BAR;
        PG8_STAGE(PG8_SB(1, 0), cB + kstep, voffB); PG8_STAGE(PG8_SA(1, 0), cA + kstep, voffA0); PG8_STAGE(PG8_SB(1, 1), cB + hstep + kstep, voffB);
        PG8_WAIT_V(6); PG8_BAR;
    }
    for (;;) {
        const bool has_next = S.next(ui + 1, nxt);
        const char* nA = cA;     const char* nB = has_next ? (const char*)g.Bt + (size_t)nxt.pn * tstep : cB;
        for (int t = 0; t < nt; t += 2) {
            const bool last = (t == nt - 2);
            const char* a1 = cA + (size_t)(t + 1) * kstep;
            const char* a2 = last ? nA : cA + (size_t)(t + 2) * kstep; const char* b2 = last ? nB : cB + (size_t)(t + 2) * kstep;
            const char* a3 = a2 + kstep; const char* b3 = b2 + kstep;
            if (last && has_next) S.a_ready(nxt);
            if constexpr (SP2) {
            PG8_LDB(B0, 0, 0); PG8_LDB(B1, 0, 1); PG8_SCHED; PG8_LDA(At, 0, 0); PG8_STAGE(PG8_SA(1, 1), a1, voffA1);
            PG8_WAIT_V(8); PG8_WAIT_L(0); PG8_BAR; PG8_MMA(0, 0, At, B0); PG8_MMA(0, 1, At, B1); PG8_BAR; PG8_SCHED;
            PG8_LDA(At, 0, 1); PG8_STAGE(PG8_SB(0, 0), b2, voffB); PG8_STAGE(PG8_SB(0, 1), b2 + hstep, voffB); PG8_STAGE(PG8_SA(0, 0), a2, voffA0);
            PG8_WAIT_V(8); PG8_WAIT_L(0); PG8_BAR; PG8_MMA(1, 0, At, B0); PG8_MMA(1, 1, At, B1); PG8_BAR; PG8_SCHED;
            PG8_LDB(B0, 1, 0); PG8_LDB(B1, 1, 1); PG8_SCHED; PG8_LDA(At, 1, 0); PG8_STAGE(PG8_SA(0, 1), a2, voffA1);
            PG8_WAIT_V(8); PG8_WAIT_L(0); PG8_BAR; PG8_MMA(0, 0, At, B0); PG8_MMA(0, 1, At, B1); PG8_BAR; PG8_SCHED;
            PG8_LDA(At, 1, 1); PG8_STAGE(PG8_SB(1, 0), b3, voffB); PG8_STAGE(PG8_SB(1, 1), b3 + hstep, voffB); PG8_STAGE(PG8_SA(1, 0), a3, voffA0);
            PG8_WAIT_V(8); PG8_WAIT_L(0); PG8_BAR; PG8_MMA(1, 0, At, B0); PG8_MMA(1, 1, At, B1); PG8_BAR; PG8_SCHED;
            } else {
            PG8_LDB(B0, 0, 0); PG8_SCHED; PG8_LDA(At, 0, 0); PG8_STAGE(PG8_SA(1, 1), a1, voffA1);
            PG8_WAIT_L(8); PG8_BAR; PG8_WAIT_L(0); PG8_MMA(0, 0, At, B0); PG8_BAR; PG8_SCHED;
            PG8_LDB(B1, 0, 1); PG8_STAGE(PG8_SB(0, 0), b2, voffB);
            PG8_BAR; PG8_WAIT_L(0); PG8_MMA(0, 1, At, B1); PG8_BAR;
            PG8_LDA(At, 0, 1); PG8_STAGE(PG8_SA(0, 0), a2, voffA0);
            PG8_BAR; PG8_WAIT_L(0); PG8_MMA(1, 0, At, B0); PG8_BAR; PG8_SCHED;
            PG8_STAGE(PG8_SB(0, 1), b2 + hstep, voffB);
            PG8_WAIT_V(6); PG8_BAR; PG8_MMA(1, 1, At, B1); PG8_BAR;
            PG8_LDB(B0, 1, 0); PG8_SCHED; PG8_LDA(At, 1, 0); PG8_STAGE(PG8_SA(0, 1), a2, voffA1);
            PG8_WAIT_L(8); PG8_BAR; PG8_WAIT_L(0); PG8_MMA(0, 0, At, B0); PG8_BAR; PG8_SCHED;
            PG8_LDB(B1, 1, 1); PG8_STAGE(PG8_SB(1, 0), b3, voffB);
            PG8_BAR; PG8_WAIT_L(0); PG8_MMA(0, 1, At, B1); PG8_BAR;
            PG8_LDA(At, 1, 1); PG8_STAGE(PG8_SA(1, 0), a3, voffA0);
            PG8_BAR; PG8_WAIT_L(0); PG8_MMA(1, 0, At, B0); PG8_BAR; PG8_SCHED;
            PG8_STAGE(PG8_SB(1, 1), b3 + hstep, voffB);
            PG8_WAIT_V(6); PG8_BAR; PG8_MMA(1, 1, At, B1); PG8_BAR;
            }
        }
        if constexpr (ALIGN_EPI) { if (wr == 0) PG8_BAR; }
        if constexpr (!Epi::AFTER_DRAIN) { E(acc, cur, wr, wc, fr, fq); S.done(cur); }
        if (!has_next) break;
#pragma unroll
        for (int a = 0; a < 2; ++a)
#pragma unroll
            for (int b = 0; b < 2; ++b)
#pragma unroll
                for (int m = 0; m < 4; ++m)
#pragma unroll
                    for (int n = 0; n < 2; ++n) acc[a][b][m][n] = (f32x4){0.f, 0.f, 0.f, 0.f};
        cur = nxt; cA = nA; cB = nB; ++ui;
        if constexpr (ALIGN_EPI) { if (wr == 1) PG8_BAR; }
    }
    PG8_WAIT_V(0);
    if constexpr (!ALIGN_EPI) { if (wr == 0) PG8_BAR; }
    PG8_BAR;
    if constexpr (Epi::AFTER_DRAIN) { E.fused(acc, cur, wr, wc, fr, fq, lds, wid, lane); S.done(cur); }
#undef PG8_SA
#undef PG8_SB
#undef PG8_STAGE
#undef PG8_LDA
#undef PG8_LDB
#undef PG8_MMA
#undef PG8_WAIT_V
#undef PG8_WAIT_L
#undef PG8_BAR
#undef PG8_SCHED
}
}

#ifndef PG8_SP2
#define PG8_SP2 false
#endif
#define GAS __attribute__((address_space(1)))
#define LAS __attribute__((address_space(3)))
typedef unsigned short bf16;
typedef unsigned v4u __attribute__((ext_vector_type(4)));
typedef unsigned v2u __attribute__((ext_vector_type(2)));
typedef float f32x4 __attribute__((ext_vector_type(4)));
#define LDS_WAIT() asm volatile("s_waitcnt lgkmcnt(0)" ::: "memory")

#ifndef MK_SPLIT
#define MK_SPLIT 0
#endif

constexpr int NTOK = 8192, SEQ = 2048, DM = 2048, NIN = 8204, NP = 8960;
constexpr int C_RR = 0, C_RK = 768, C_RV = 1536, C_RG = 2304, C_TQ = 3072, C_TK = 3584, C_TV = 4096, C_TG = 4608, C_DQ = 5120, C_DZ = 7424, C_DA = 8192, C_DB = 8198;
constexpr int C_P1W = 8208, C_P2W = 8304, C_P1A = 8400, C_P2A = 8496, C_P1V = 8592, C_P2V = 8656, C_END = 8720;
constexpr int NLR = 2304, NOR = 1280, MAXROWS = 24576;
constexpr int NWAVES = 8, NTHR = 512;

constexpr size_t MiB = 1u << 20;
constexpr size_t WS_CTL = 0, CTL_BYTES = 1 * MiB;
constexpr size_t WS_WIN = WS_CTL + CTL_BYTES;
constexpr size_t WS_WOUT = WS_WIN + (size_t)NP * DM * 2;
constexpr size_t WS_W13 = WS_WOUT + (size_t)DM * DM * 2;
constexpr size_t WS_W2 = WS_W13 + (size_t)32 * 512 * DM * 2;
constexpr size_t WS_LR2 = WS_W2 + (size_t)32 * DM * 256 * 2;
constexpr size_t WS_RW = WS_LR2 + (size_t)NLR * 256 * 2;
constexpr size_t WS_H = WS_RW + (size_t)DM * 48 * 4;
constexpr size_t WS_MIX = WS_H + (size_t)NTOK * DM * 2;
constexpr size_t WS_XBUF = WS_MIX + (size_t)NTOK * DM * 2;
constexpr size_t WS_BIG = WS_XBUF + (size_t)NTOK * DM * 4;
constexpr size_t WS_PROJ = WS_BIG;
constexpr size_t WS_LR = WS_PROJ + (size_t)NTOK * NP * 2;
constexpr size_t WS_ORAW = WS_LR + (size_t)NTOK * NLR * 2;
constexpr size_t BIG_A = (size_t)NTOK * NP * 2 + (size_t)NTOK * NLR * 2 + (size_t)NTOK * NOR * 4;
constexpr size_t WS_SA = WS_BIG;
constexpr size_t WS_YS = WS_SA + (size_t)MAXROWS * DM * 2;
constexpr size_t BIG_B = (size_t)2 * MAXROWS * DM * 2;
constexpr size_t WS_HID = WS_BIG + (BIG_A > BIG_B ? BIG_A : BIG_B);
constexpr size_t WS_A2 = WS_HID + (size_t)MAXROWS * 256 * 2;
constexpr size_t WS_VF = WS_A2 + (size_t)NTOK * 256 * 2;
constexpr size_t WS_ROUTE = WS_VF + (size_t)NTOK * 768 * 4;
constexpr size_t WS_GATE = WS_ROUTE + (size_t)NTOK * 16;
constexpr size_t WS_POS = WS_GATE + (size_t)NTOK * 8;
constexpr size_t WS_BLOBG = WS_POS + (size_t)NTOK * 8;
constexpr size_t WS_PCS = WS_BLOBG + (size_t)768 * 106496;
constexpr size_t WS_BON = WS_PCS + (size_t)(1536 * 64 + 768 * 128 + 512 * 128) * 4;
constexpr size_t WS_ROWTOK = WS_BON + (size_t)NTOK * 12 * 4;
constexpr size_t WS_END = WS_ROWTOK + (size_t)MAXROWS * 4;
constexpr size_t WS_W2X = WS_XBUF + (size_t)NTOK * DM * 2;
constexpr size_t WS_BLOBW = WS_W13;
constexpr size_t WS_BLOBR = WS_H;
static_assert((size_t)1536 * 65536 <= (size_t)32 * 512 * DM * 2 + (size_t)32 * DM * 256 * 2 && (size_t)512 * 57344 <= (size_t)NTOK * DM * 2 && WS_END <= 643000000, "workspace map");
constexpr int CW_BAR = 1024;
constexpr int CW_P1 = 64;
constexpr int CW_CNT = 8192;

constexpr int RING_BYTES = 131072, MISC_OFF = 146432, LDS_BYTES = 163840;
static_assert(TIDTAB_OFF >= MISC_OFF + 1024 && TIDTAB_OFF + 16384 <= LDS_BYTES, "LDS map");

__device__ __forceinline__ float bf2f(bf16 v) { return __builtin_bit_cast(float, (unsigned)v << 16); }
__device__ __forceinline__ unsigned f2bf(float f) { unsigned u = __builtin_bit_cast(unsigned, f); return (u + 0x7fffu + ((u >> 16) & 1u)) >> 16; }
__device__ __forceinline__ unsigned pk2(float lo, float hi) { return f2bf(lo) | (f2bf(hi) << 16); }
typedef __bf16 hb2_t __attribute__((ext_vector_type(2)));
typedef float hf2_t __attribute__((ext_vector_type(2)));
__device__ __forceinline__ unsigned pk2h(float lo, float hi) { const hf2_t v = {lo, hi}; const hb2_t b = __builtin_convertvector(v, hb2_t); return __builtin_bit_cast(unsigned, b); }
__device__ __forceinline__ unsigned f2bfh(float f) { return pk2h(f, f) & 0xffffu; }
__device__ __forceinline__ void unpk4(v2u p, float (&f)[4]) { f[0] = __builtin_bit_cast(float, p.x << 16); f[1] = __builtin_bit_cast(float, p.x & 0xffff0000u); f[2] = __builtin_bit_cast(float, p.y << 16); f[3] = __builtin_bit_cast(float, p.y & 0xffff0000u); }
__device__ __forceinline__ void unpk8(v4u p, float (&f)[8]) { f[0] = __builtin_bit_cast(float, p.x << 16); f[1] = __builtin_bit_cast(float, p.x & 0xffff0000u); f[2] = __builtin_bit_cast(float, p.y << 16); f[3] = __builtin_bit_cast(float, p.y & 0xffff0000u);
    f[4] = __builtin_bit_cast(float, p.z << 16); f[5] = __builtin_bit_cast(float, p.z & 0xffff0000u); f[6] = __builtin_bit_cast(float, p.w << 16); f[7] = __builtin_bit_cast(float, p.w & 0xffff0000u); }
__device__ __forceinline__ float sigmoidf_(float x) { return __builtin_amdgcn_rcpf(1.0f + __expf(-x)); }
__device__ __forceinline__ float siluf_(float x) { return x * __builtin_amdgcn_rcpf(1.0f + __expf(-x)); }
template <int CTRL> __device__ __forceinline__ float dppf(float x) { return __builtin_bit_cast(float, __builtin_amdgcn_mov_dpp(__builtin_bit_cast(int, x), CTRL, 0xf, 0xf, true)); }
__device__ __forceinline__ float red8(float v) { v += dppf<0xB1>(v); v += dppf<0x4E>(v); v += dppf<0x141>(v); return v; }
__device__ __forceinline__ float red16(float v) { v = red8(v); v += dppf<0x128>(v); return v; }
__device__ __forceinline__ float wave_sum(float v) {
    v = red16(v);
    v += __builtin_bit_cast(float, __builtin_amdgcn_update_dpp(0, __builtin_bit_cast(int, v), 0x142, 0xa, 0xf, false));
    v += __builtin_bit_cast(float, __builtin_amdgcn_update_dpp(0, __builtin_bit_cast(int, v), 0x143, 0xc, 0xf, false));
    return __builtin_bit_cast(float, __builtin_amdgcn_readlane(__builtin_bit_cast(int, v), 63));
}

struct Args { const void* in[36]; float* out; unsigned char* ws; int ph_lo, ph_hi; };

enum { I_X = 0, I_POS, I_N1W, I_WIN, I_WOUT, I_MU_RKVG, I_MU_WA, I_W0, I_W1, I_W2, I_A0, I_A1, I_A2, I_KK, I_KA, I_RK, I_LNW, I_LNB, I_MU_V, I_V0, I_V1, I_V2,
       I_RET_GN, I_CONVW, I_ALOG, I_DTB, I_GDN_NW, I_N2W, I_MGW, I_MGB, I_MEW, I_MEB, I_MW1, I_MW3, I_MW2, I_FNW };

typedef const Args __attribute__((address_space(4)))* CArgs;
#define INF(i) ((const float*)Ap->in[i])

__device__ __forceinline__ void tr_item(const float* W, int ldn, int nsrc, int ndst, const float* sc, int scmode, bf16* __restrict__ WT, int Kd, int k0, int n0, size_t drow0, LAS float* scr, int lane) {
    const int col = lane & 31;
    const bool okc = (n0 + col < nsrc); const int cc = okc ? (n0 + col) : 0; const float mkc = okc ? 1.f : 0.f;
    const float* Wc = (nsrc > 0) ? W : sc;
    const float* wp = Wc + ((nsrc > 0) ? ((size_t)(k0 + (lane >> 5)) * ldn + cc) : 0); const size_t wstep = (nsrc > 0) ? (size_t)2 * ldn : 0;
#pragma unroll
    for (int i = 0; i < 32; ++i) { const int kk = 2 * i + (lane >> 5); float v = __builtin_nontemporal_load(wp + i * wstep) * mkc;
        if (scmode) { const float s = sc[k0 + kk]; v *= (scmode == 1 ? 1.0f - s : s); }
        scr[kk * 33 + col] = v; }
    LDS_WAIT(); asm volatile("" ::: "memory");
    const int c = lane & 7;
#pragma unroll
    for (int j = 0; j < 4; ++j) { const int n = (lane >> 3) + 8 * j; const LAS float* s = scr + (8 * c) * 33 + n;
        v4u o; o.x = pk2(s[0 * 33], s[1 * 33]); o.y = pk2(s[2 * 33], s[3 * 33]); o.z = pk2(s[4 * 33], s[5 * 33]); o.w = pk2(s[6 * 33], s[7 * 33]);
        if (n0 + n < ndst) *(v4u*)(WT + (drow0 + n) * (size_t)Kd + k0 + 8 * c) = o; }
    LDS_WAIT(); asm volatile("" ::: "memory");
}

template <int PART  > __device__ __forceinline__ void phase_convert(CArgs Ap, int l, LAS unsigned char* lds, int bidx, int nblk, int r0 = 0, int r1 = 1 << 30) {
    const int tid = otid(), lane = tid & 63, wave = __builtin_amdgcn_readfirstlane(tid >> 6);
    LAS float* scr = (LAS float*)(lds + wave * 8704);
    const int gw = bidx * NWAVES + wave, NGW = nblk * NWAVES;
    unsigned char* ws = Ap->ws;
    bf16* WinT = (bf16*)(ws + WS_WIN); bf16* WoutT = (bf16*)(ws + WS_WOUT); bf16* W13T = (bf16*)(ws + WS_W13); bf16* W2T = (bf16*)(ws + WS_W2X);
    constexpr int I_IN = 32 * 257, I_EX = 32 * 16, I_OUT = 32 * 64, I_M13 = 32 * 2 * 32 * 8, I_M2 = 32 * 4 * 64;
    constexpr int NITEMS = I_IN + I_EX + I_OUT + I_M13 + I_M2;
    constexpr int IT_LO = (PART == 0) ? 0 : (PART == 1) ? I_IN + I_EX + I_OUT : I_IN + I_EX + I_OUT + I_M13, IT_HI = (PART == 0) ? I_IN + I_EX + I_OUT : (PART == 1) ? I_IN + I_EX + I_OUT + I_M13 : NITEMS;
    const int it_hi = (r1 < IT_HI - IT_LO) ? IT_LO + r1 : IT_HI;
    for (int it = IT_LO + r0 + gw; it < it_hi; it += NGW) {
        int r = it;
        if (r < I_IN) { const int kb = r / 257, nb = r % 257;
            tr_item(INF(I_WIN) + (size_t)l * DM * NIN, NIN, NIN, 8208, nullptr, 0, WinT, DM, 64 * kb, 32 * nb, (size_t)32 * nb, scr, lane); continue; }
        r -= I_IN;
        if (r < I_EX) { const int kb = r / 16, sub = r % 16;
            const float* W; const float* sc; int mode, nloc, ldn, nsrc; size_t drow;
            if (sub < 3)       { W = INF(I_W1) + (size_t)l * DM * 96; sc = INF(I_MU_WA) + (size_t)(l * 2 + 0) * DM; mode = 1; nloc = sub;      ldn = 96; nsrc = 96; drow = C_P1W; }
            else if (sub < 6)  { W = INF(I_W1) + (size_t)l * DM * 96; sc = INF(I_MU_WA) + (size_t)(l * 2 + 0) * DM; mode = 2; nloc = sub - 3;  ldn = 96; nsrc = 96; drow = C_P2W; }
            else if (sub < 9)  { W = INF(I_A1) + (size_t)l * DM * 96; sc = INF(I_MU_WA) + (size_t)(l * 2 + 1) * DM; mode = 1; nloc = sub - 6;  ldn = 96; nsrc = 96; drow = C_P1A; }
            else if (sub < 12) { W = INF(I_A1) + (size_t)l * DM * 96; sc = INF(I_MU_WA) + (size_t)(l * 2 + 1) * DM; mode = 2; nloc = sub - 9;  ldn = 96; nsrc = 96; drow = C_P2A; }
            else if (sub < 14) { W = INF(I_V1); sc = INF(I_MU_V); mode = 1; nloc = sub - 12; ldn = 64; nsrc = (l > 0) ? 64 : 0; drow = C_P1V; }
            else               { W = INF(I_V1); sc = INF(I_MU_V); mode = 2; nloc = sub - 14; ldn = 64; nsrc = (l > 0) ? 64 : 0; drow = C_P2V; }
            tr_item(W, ldn, nsrc, 1 << 30, sc, mode, WinT, DM, 64 * kb, 32 * nloc, drow + 32 * nloc, scr, lane); continue; }
        r -= I_EX;
        if (r < I_OUT) { const int kb = r / 64, nb = r % 64;
            tr_item(INF(I_WOUT) + (size_t)l * DM * DM, DM, DM, 1 << 30, nullptr, 0, WoutT, DM, 64 * kb, 32 * nb, (size_t)32 * nb, scr, lane); continue; }
        r -= I_OUT;
        if (r < I_M13) { const int e = r / 512, r1 = r % 512, mat = r1 / 256, r2 = r1 % 256, kb = r2 / 8, nb = r2 % 8;
            const float* W = INF(mat ? I_MW3 : I_MW1) + (size_t)(l * 32 + e) * DM * 256;
            const int f0 = 32 * nb, pn = f0 / 128, j0 = f0 % 128;
            tr_item(W, 256, 256, 1 << 30, nullptr, 0, W13T, DM, 64 * kb, f0, (size_t)e * 512 + pn * 256 + mat * 128 + j0, scr, lane); continue; }
        r -= I_M13;
        { const int e = r / 256, r1 = r % 256, kb = r1 / 64, nb = r1 % 64;
            tr_item(INF(I_MW2) + (size_t)(l * 32 + e) * 256 * DM, DM, DM, 1 << 30, nullptr, 0, W2T, 256, 64 * kb, 32 * nb, (size_t)e * DM + 32 * nb, scr, lane); }
    }
    if (PART != 0) return;
    const size_t gt = (size_t)bidx * NTHR + tid, NGT = (size_t)nblk * NTHR;
    { v4u* z = (v4u*)(WinT + (size_t)C_END * DM); const size_t n16 = (size_t)(NP - C_END) * DM / 8; const v4u zero = {0u, 0u, 0u, 0u};
        for (size_t i = gt; i < n16; i += NGT) z[i] = zero; }
    { bf16* LR2T = (bf16*)(ws + WS_LR2);
        const float* w2 = INF(I_W2) + (size_t)l * 96 * 768; const float* a2 = INF(I_A2) + (size_t)l * 96 * 768; const float* v2 = INF(I_V2);
        for (size_t i = gt; i < (size_t)NLR * 256; i += NGT) { const int n = (int)(i >> 8), k = (int)(i & 255); float v = 0.f;
            if (n < 768) { if (k < 96) v = w2[(size_t)k * 768 + n]; }
            else if (n < 1536) { if (k >= 96 && k < 192) v = a2[(size_t)(k - 96) * 768 + (n - 768)]; }
            else { if (k >= 192 && l > 0) v = v2[(size_t)(k - 192) * 768 + (n - 1536)]; }
            LR2T[i] = (bf16)f2bf(v); } }
    { float* RW = (float*)(ws + WS_RW); const float* nw = INF(I_N2W) + (size_t)l * DM; const float* gwp = INF(I_MGW) + (size_t)l * DM * 4; const float* ewp = INF(I_MEW) + (size_t)l * DM * 32;
        for (size_t i = gt; i < (size_t)DM * 48; i += NGT) { const int n = (int)(i / DM), k = (int)(i % DM); float v = 0.f;
            if (n < 4) v = gwp[k * 4 + n]; else if (n < 36) v = ewp[k * 32 + (n - 4)];
            RW[i] = v * nw[k]; } }
}

__device__ __forceinline__ void convert_w2_pipe(CArgs Ap, int l, LAS unsigned char* lds, int bidx, int nblk, int r0, int r1) {
    const int tid = otid(), lane = tid & 63, wave = __builtin_amdgcn_readfirstlane(tid >> 6);
    LAS float* scr = (LAS float*)(lds + wave * 8704);
    const int gw = bidx * NWAVES + wave, NGW = nblk * NWAVES;
    bf16* __restrict__ W2T = (bf16*)(Ap->ws + WS_W2X); const float* W2 = INF(I_MW2) + (size_t)l * 32 * 256 * DM;
    const int col = lane & 31, kh = lane >> 5;
#define W2_SRC(it_) (W2 + (size_t)((it_) >> 8) * 256 * DM + (size_t)(64 * (((it_) & 255) >> 6) + kh) * DM + 32 * ((it_) & 63) + col)
#define W2_LOAD(dst, it_) do { const int ic_ = ((it_) < r1) ? (it_) : (r1 - 1); const float* wp_ = W2_SRC(ic_); _Pragma("unroll") for (int i = 0; i < 32; ++i) dst[i] = __builtin_nontemporal_load(wp_ + (size_t)i * 2 * DM); } while (0)
#define W2_PROC(src, it_) do { _Pragma("unroll") for (int i = 0; i < 32; ++i) scr[(2 * i + kh) * 33 + col] = src[i]; \
        LDS_WAIT(); asm volatile("" ::: "memory"); \
        { const int e_ = (it_) >> 8, kb_ = ((it_) & 255) >> 6, nb_ = (it_) & 63, c_ = lane & 7; \
          _Pragma("unroll") for (int j = 0; j < 4; ++j) { const int n_ = (lane >> 3) + 8 * j; const LAS float* s_ = scr + (8 * c_) * 33 + n_; \
            v4u o_; o_.x = pk2(s_[0 * 33], s_[1 * 33]); o_.y = pk2(s_[2 * 33], s_[3 * 33]); o_.z = pk2(s_[4 * 33], s_[5 * 33]); o_.w = pk2(s_[6 * 33], s_[7 * 33]); \
            *(v4u*)(W2T + ((size_t)e_ * DM + 32 * nb_ + n_) * 256 + 64 * kb_ + 8 * c_) = o_; } } \
        LDS_WAIT(); asm volatile("" ::: "memory"); } while (0)
    float va[32], vb[32];
    int it = r0 + gw;
    if (it < r1) {
        W2_LOAD(va, it);
        for (;;) {
            W2_LOAD(vb, it + NGW); W2_PROC(va, it); it += NGW; if (it >= r1) break;
            W2_LOAD(va, it + NGW); W2_PROC(vb, it); it += NGW; if (it >= r1) break;
        }
    }
#undef W2_SRC
#undef W2_LOAD
#undef W2_PROC
}

__device__ __forceinline__ void phase_norm(CArgs Ap, int mode, int l) {
    const int tid = otid(), lane = tid & 63, wave = __builtin_amdgcn_readfirstlane(tid >> 6);
    const int gw = blockIdx.x * NWAVES + wave, NGW = gridDim.x * NWAVES;
    unsigned char* ws = Ap->ws;
    bf16* XBUF = (bf16*)(ws + WS_XBUF); bf16* __restrict__ H = (bf16*)(ws + WS_H); float* __restrict__ OUTF = Ap->out;
    const bf16* YS = (const bf16*)(ws + WS_YS); const int* POS = (const int*)(ws + WS_POS); const float* GATE = (const float*)(ws + WS_GATE);
    const float* nw = (mode == 2) ? INF(I_FNW) : INF(I_N1W) + (size_t)l * DM;
#pragma unroll 2
    for (int m = gw; m < NTOK; m += NGW) {
        float v[4][8];
        if (mode == 0) { const float* src = INF(I_X) + (size_t)m * DM;
#pragma unroll
            for (int j = 0; j < 4; ++j) { const f32x4 a = *((const f32x4*)src + 2 * (lane + 64 * j)), b = *((const f32x4*)src + 2 * (lane + 64 * j) + 1);
                v[j][0] = a.x; v[j][1] = a.y; v[j][2] = a.z; v[j][3] = a.w; v[j][4] = b.x; v[j][5] = b.y; v[j][6] = b.z; v[j][7] = b.w; }
        } else {
            const int p0 = POS[2 * m], p1 = POS[2 * m + 1]; const float g0 = GATE[2 * m], g1 = GATE[2 * m + 1];
            v4u xv[4], ya[4], yb[4];
#pragma unroll
            for (int j = 0; j < 4; ++j) { xv[j] = *((const v4u*)(XBUF + (size_t)m * DM) + lane + 64 * j); ya[j] = *((const v4u*)(YS + (size_t)p0 * DM) + lane + 64 * j); yb[j] = *((const v4u*)(YS + (size_t)p1 * DM) + lane + 64 * j); }
#pragma unroll
            for (int j = 0; j < 4; ++j) { float fa[8], fb[8]; unpk8(xv[j], v[j]); unpk8(ya[j], fa); unpk8(yb[j], fb);
#pragma unroll
                for (int e = 0; e < 8; ++e) v[j][e] += g0 * fa[e] + g1 * fb[e]; }
            if (mode == 1) {
#pragma unroll
                for (int j = 0; j < 4; ++j) { v4u o; o.x = pk2(v[j][0], v[j][1]); o.y = pk2(v[j][2], v[j][3]); o.z = pk2(v[j][4], v[j][5]); o.w = pk2(v[j][6], v[j][7]);
                    *((v4u*)(XBUF + (size_t)m * DM) + lane + 64 * j) = o; } }
        }
        float ss = 0.f;
#pragma unroll
        for (int j = 0; j < 4; ++j) ss += ((v[j][0] * v[j][0] + v[j][1] * v[j][1]) + (v[j][2] * v[j][2] + v[j][3] * v[j][3])) + ((v[j][4] * v[j][4] + v[j][5] * v[j][5]) + (v[j][6] * v[j][6] + v[j][7] * v[j][7]));
        const float rstd = rsqrtf(wave_sum(ss) * (1.0f / DM) + 1e-6f);
#pragma unroll
        for (int j = 0; j < 4; ++j) { const f32x4 w0 = *((const f32x4*)nw + 2 * (lane + 64 * j)), w1 = *((const f32x4*)nw + 2 * (lane + 64 * j) + 1);
            const f32x4 y0 = (f32x4){v[j][0], v[j][1], v[j][2], v[j][3]} * rstd * w0, y1 = (f32x4){v[j][4], v[j][5], v[j][6], v[j][7]} * rstd * w1;
            if (mode == 2) { *((f32x4*)(OUTF + (size_t)m * DM) + 2 * (lane + 64 * j)) = y0; *((f32x4*)(OUTF + (size_t)m * DM) + 2 * (lane + 64 * j) + 1) = y1; }
            else { v4u o; o.x = pk2(y0.x, y0.y); o.y = pk2(y0.z, y0.w); o.z = pk2(y1.x, y1.y); o.w = pk2(y1.z, y1.w); *((v4u*)(H + (size_t)m * DM) + lane + 64 * j) = o; } }
    }
}

__device__ __forceinline__ void phase_e1(CArgs Ap, int l) {
    const bf16* PROJ = (const bf16*)(Ap->ws + WS_PROJ); bf16* __restrict__ A2 = (bf16*)(Ap->ws + WS_A2);
    const size_t gt = (size_t)blockIdx.x * NTHR + otid(), NGT = (size_t)gridDim.x * NTHR;
    for (size_t i = gt; i < (size_t)NTOK * 256; i += NGT) { const int m = (int)(i >> 8), j = (int)(i & 255); const bool hp = (m % SEQ) > 0;
        int c1, c2, jj; if (j < 96) { c1 = C_P1W; c2 = C_P2W; jj = j; } else if (j < 192) { c1 = C_P1A; c2 = C_P2A; jj = j - 96; } else { c1 = C_P1V; c2 = C_P2V; jj = j - 192; }
        float v = bf2f(PROJ[(size_t)m * NP + c1 + jj]) + (hp ? 1.f : 0.f) * bf2f(PROJ[(size_t)(hp ? m - 1 : m) * NP + c2 + jj]);
        if (j < 96) v = 1.0f - 2.0f * __builtin_amdgcn_rcpf(1.0f + __expf(2.0f * v));
        if (j >= 192 && l == 0) v = 0.f;
        A2[i] = (bf16)f2bf(v); }
}

__device__ __forceinline__ void phase_r1(CArgs Ap, int l, LAS unsigned char* lds) {
    const int tid = otid(), lane = tid & 63, wave = __builtin_amdgcn_readfirstlane(tid >> 6);
    const bf16* XBUF = (const bf16*)(Ap->ws + WS_XBUF); bf16* __restrict__ XN = (bf16*)(Ap->ws + WS_H); const float* RW = (const float*)(Ap->ws + WS_RW);
    unsigned* CNT = (unsigned*)(Ap->ws + WS_CTL) + CW_CNT + 8192 * l; int* ROUTE = (int*)(Ap->ws + WS_ROUTE); float* GATE = (float*)(Ap->ws + WS_GATE);
    const float* nw = INF(I_N2W) + (size_t)l * DM;
    LAS float* RSTD = (LAS float*)lds;
    LAS float* LOG = RSTD + 32;
    LAS float* LPART = LOG + 32 * 48;
    for (int tb = blockIdx.x; tb < NTOK / 32; tb += gridDim.x) { const int m0 = tb * 32;
#pragma unroll 1
        for (int j = 0; j < 4; ++j) { const int r = wave * 4 + j; const size_t m = (size_t)m0 + r;
            float v[4][8]; float ss = 0.f; v4u xv[4];
#pragma unroll
            for (int jj = 0; jj < 4; ++jj) xv[jj] = *((const v4u*)(XBUF + m * DM) + lane + 64 * jj);
#pragma unroll
            for (int jj = 0; jj < 4; ++jj) { unpk8(xv[jj], v[jj]);
                ss += ((v[jj][0] * v[jj][0] + v[jj][1] * v[jj][1]) + (v[jj][2] * v[jj][2] + v[jj][3] * v[jj][3])) + ((v[jj][4] * v[jj][4] + v[jj][5] * v[jj][5]) + (v[jj][6] * v[jj][6] + v[jj][7] * v[jj][7])); }
            const float rstd = rsqrtf(wave_sum(ss) * (1.0f / DM) + 1e-6f);
            if (lane == 0) RSTD[r] = rstd;
#pragma unroll
            for (int jj = 0; jj < 4; ++jj) { const f32x4 w0 = *((const f32x4*)nw + 2 * (lane + 64 * jj)), w1 = *((const f32x4*)nw + 2 * (lane + 64 * jj) + 1);
                const f32x4 y0 = (f32x4){v[jj][0], v[jj][1], v[jj][2], v[jj][3]} * rstd * w0, y1 = (f32x4){v[jj][4], v[jj][5], v[jj][6], v[jj][7]} * rstd * w1;
                v4u o; o.x = pk2(y0.x, y0.y); o.y = pk2(y0.z, y0.w); o.z = pk2(y1.x, y1.y); o.w = pk2(y1.z, y1.w); *((v4u*)(XN + m * DM) + lane + 64 * jj) = o; } }
        { const int fr = lane & 15, fq = lane >> 4;
            const bf16* xa = XBUF + (size_t)(m0 + fr) * DM + 256 * wave + 8 * fq; const float* wb = RW + (size_t)fr * DM + 256 * wave + 8 * fq;
            f32x4 acc[2][3];
#pragma unroll
            for (int a = 0; a < 2; ++a)
#pragma unroll
                for (int b = 0; b < 3; ++b) acc[a][b] = (f32x4){0.f, 0.f, 0.f, 0.f};
#pragma unroll 2
            for (int s = 0; s < 8; ++s) {
                float a0[8], a1[8]; unpk8(*(const v4u*)(xa + 32 * s), a0); unpk8(*(const v4u*)(xa + 16 * DM + 32 * s), a1);
                const f32x4 b0l = *(const f32x4*)(wb + 32 * s), b0h = *(const f32x4*)(wb + 32 * s + 4), b1l = *(const f32x4*)(wb + 16 * DM + 32 * s), b1h = *(const f32x4*)(wb + 16 * DM + 32 * s + 4),
                            b2l = *(const f32x4*)(wb + 32 * DM + 32 * s), b2h = *(const f32x4*)(wb + 32 * DM + 32 * s + 4);
#pragma unroll
                for (int i = 0; i < 8; ++i) { const float e0 = (i < 4) ? b0l[i & 3] : b0h[i & 3], e1 = (i < 4) ? b1l[i & 3] : b1h[i & 3], e2 = (i < 4) ? b2l[i & 3] : b2h[i & 3];
                    acc[0][0] = __builtin_amdgcn_mfma_f32_16x16x4f32(a0[i], e0, acc[0][0], 0, 0, 0); acc[0][1] = __builtin_amdgcn_mfma_f32_16x16x4f32(a0[i], e1, acc[0][1], 0, 0, 0);
                    acc[0][2] = __builtin_amdgcn_mfma_f32_16x16x4f32(a0[i], e2, acc[0][2], 0, 0, 0); acc[1][0] = __builtin_amdgcn_mfma_f32_16x16x4f32(a1[i], e0, acc[1][0], 0, 0, 0);
                    acc[1][1] = __builtin_amdgcn_mfma_f32_16x16x4f32(a1[i], e1, acc[1][1], 0, 0, 0); acc[1][2] = __builtin_amdgcn_mfma_f32_16x16x4f32(a1[i], e2, acc[1][2], 0, 0, 0); } }
#pragma unroll
            for (int a = 0; a < 2; ++a)
#pragma unroll
                for (int b = 0; b < 3; ++b)
#pragma unroll
                    for (int i = 0; i < 4; ++i) LPART[(wave * 32 + a * 16 + 4 * fq + i) * 48 + b * 16 + fr] = acc[a][b][i]; }
        __syncthreads();
#pragma unroll
        for (int q = 0; q < 3; ++q) { const int e = tid + NTHR * q; float s = 0.f;
#pragma unroll
            for (int w = 0; w < 8; ++w) s += LPART[w * 32 * 48 + e];
            LOG[e] = s * RSTD[e / 48]; }
        __syncthreads();
        LAS int* EL = (LAS int*)(LPART);
        float gA = 0.f, gB = 0.f; int e0 = 0, e1 = 0;
        if (tid < 32) { const LAS float* lg = LOG + tid * 48; const float* gb = INF(I_MGB) + l * 4; const float* eb = INF(I_MEB) + l * 32;
            float gmax = -3.0e38f; int gi = 0;
            for (int i = 0; i < 4; ++i) { const float v = lg[i] + gb[i]; if (v > gmax) { gmax = v; gi = i; } }
            float gden = 0.f;
            for (int i = 0; i < 4; ++i) gden += __expf(lg[i] + gb[i] - gmax);
            const float gg = 1.0f / gden;
            float b1 = -3.0e38f; int i1 = 0;
            for (int i = 0; i < 8; ++i) { const float v = lg[4 + gi * 8 + i] + eb[gi * 8 + i]; if (v > b1) { b1 = v; i1 = i; } }
            float b2 = -3.0e38f; int i2 = 0;
            for (int i = 0; i < 8; ++i) { const float v = lg[4 + gi * 8 + i] + eb[gi * 8 + i]; if (i != i1 && v > b2) { b2 = v; i2 = i; } }
            const float wA = 1.0f / (1.0f + __expf(b2 - b1)), wB = 1.0f - wA;
            e0 = gi * 8 + i1; e1 = gi * 8 + i2; gA = gg * wA; gB = gg * wB;
            EL[tid] = e0; EL[32 + tid] = e1; }
        __syncthreads();
        if (tid < 32) {
            int r0 = 0, r1 = 0, cnt = 0;
            for (int t2 = 0; t2 < 32; ++t2) { const int a0 = EL[t2], a1 = EL[32 + t2];
                if (t2 < tid) { r0 += (a0 == e0) + (a1 == e0); r1 += (a0 == e1) + (a1 == e1); }
                cnt += (a0 == tid) + (a1 == tid); }
            const size_t m = (size_t)m0 + tid;
            ROUTE[m * 4 + 0] = e0; ROUTE[m * 4 + 1] = e1; ROUTE[m * 4 + 2] = r0; ROUTE[m * 4 + 3] = r1;
            GATE[m * 2] = gA; GATE[m * 2 + 1] = gB;
            CNT[(size_t)tb * 32 + tid] = (unsigned)cnt; }
        __syncthreads();
    }
}

__device__ __forceinline__ void compute_toff(CArgs Ap, int l, LAS unsigned char* lds, int tb) {
    const int tid = otid();
    const unsigned* CNT = (const unsigned*)(Ap->ws + WS_CTL) + CW_CNT + 8192 * l;
    LAS int* TOFF = (LAS int*)(lds + MISC_OFF + 64); LAS int* CL = TOFF + 40; LAS int* BASE = TOFF + 176; LAS int* PART = (LAS int*)lds;
    __syncthreads();
    { const int e = tid & 31, part = tid >> 5; int tot = 0, bs = 0;
        for (int i = 0; i < 16; ++i) { const int b = part * 16 + i; const int c = (int)CNT[(size_t)b * 32 + e]; tot += c; if (b < tb) bs += c; }
        PART[part * 32 + e] = tot; PART[512 + part * 32 + e] = bs; }
    __syncthreads();
    if (tid < 32) { int tot = 0, bs = 0; for (int p = 0; p < 16; ++p) { tot += PART[p * 32 + tid]; bs += PART[512 + p * 32 + tid]; } CL[tid] = tot; BASE[tid] = bs; }
    __syncthreads();
    if (tid == 0) { int acc = 0; for (int e = 0; e < 32; ++e) { TOFF[e] = acc; acc += (CL[e] + 255) >> 8; } TOFF[32] = acc; }
    __syncthreads();
    if (tid < 96) { int e = 0; for (int j = 1; j < 32; ++j) e += (TOFF[j] <= tid) ? 1 : 0; TOFF[80 + tid] = e; }
    __syncthreads();
}
constexpr int RT_OFF = RING_BYTES;
__device__ __forceinline__ void g3_rowtok(CArgs Ap, int l, LAS unsigned char* lds, int c) {
    const int tid = otid(), lane = tid & 63, wave = __builtin_amdgcn_readfirstlane(tid >> 6);
    LAS int* TOFF = (LAS int*)(lds + MISC_OFF + 64); LAS int* RT = (LAS int*)(lds + RT_OFF); LAS int* BS = RT + 256; LAS int* WTOT = BS + 256;
    const int ntiles = __builtin_amdgcn_readfirstlane(TOFF[32]);
    if (c >= 2 * ntiles) return;
    const int pm = c >> 1, pl = c & 1, e = __builtin_amdgcn_readfirstlane(TOFF[80 + pm]), ebase = __builtin_amdgcn_readfirstlane(TOFF[e]) * 256, lo = pm * 256 - ebase;
    const unsigned* CNT = (const unsigned*)(Ap->ws + WS_CTL) + CW_CNT + 8192 * l; const int* ROUTE = (const int*)(Ap->ws + WS_ROUTE); int* POS = (int*)(Ap->ws + WS_POS);
    typedef int v4i __attribute__((ext_vector_type(4)));
    v4i rt4[16];
#pragma unroll
    for (int k = 0; k < 16; ++k) rt4[k] = *(const v4i*)(ROUTE + (size_t)(tid + NTHR * k) * 4);
    int v = 0, incl = 0;
    if (tid < 256) { v = (int)CNT[(size_t)tid * 32 + e]; incl = v;
#define ISCAN(ctl, rm, bc) incl += __builtin_amdgcn_update_dpp(0, incl, ctl, rm, 0xf, bc)
        ISCAN(0x111, 0xf, true); ISCAN(0x112, 0xf, true); ISCAN(0x114, 0xf, true); ISCAN(0x118, 0xf, true); ISCAN(0x142, 0xa, false); ISCAN(0x143, 0xc, false);
#undef ISCAN
        if (lane == 63) WTOT[wave] = incl;
        RT[tid] = 0; }
    __syncthreads();
    if (tid < 256) { int off = 0;
#pragma unroll
        for (int w = 0; w < 3; ++w) off += (w < wave) ? WTOT[w] : 0;
        BS[tid] = off + incl - v; }
    __syncthreads();
#pragma unroll
    for (int k = 0; k < 16; ++k) { const int m = tid + NTHR * k; const int bs = BS[m >> 5];
        if (rt4[k].x == e) { const int p = bs + rt4[k].z; if (p >= lo && p < lo + 256) { RT[p - lo] = m; if (pl == 0) POS[2 * m] = ebase + p; } }
        if (rt4[k].y == e) { const int p = bs + rt4[k].w; if (p >= lo && p < lo + 256) { RT[p - lo] = m; if (pl == 0) POS[2 * m + 1] = ebase + p; } } }
    __syncthreads();
}
__device__ __forceinline__ void phase_r2(CArgs Ap, int l, LAS unsigned char* lds) {
    const int* ROUTE = (const int*)(Ap->ws + WS_ROUTE); int* POS = (int*)(Ap->ws + WS_POS); int* ROWTOK = (int*)(Ap->ws + WS_ROWTOK);
    LAS int* TOFF = (LAS int*)(lds + MISC_OFF + 64); LAS int* CL = TOFF + 40; LAS int* BASE = TOFF + 176;
    for (int tb = blockIdx.x; tb < NTOK / 32; tb += gridDim.x) {
        compute_toff(Ap, l, lds, tb);
        const int tid = otid();
        if (tid < 32) { const int m = tb * 32 + tid;
            const int e0 = ROUTE[m * 4], e1 = ROUTE[m * 4 + 1], r0 = ROUTE[m * 4 + 2], r1 = ROUTE[m * 4 + 3];
            const int d0 = TOFF[e0] * 256 + BASE[e0] + r0, d1 = TOFF[e1] * 256 + BASE[e1] + r1;
            POS[2 * m] = d0; POS[2 * m + 1] = d1; ROWTOK[d0] = m; ROWTOK[d1] = m; }
        if (tb < 32) { const int lo = TOFF[tb] * 256 + CL[tb], hi = TOFF[tb + 1] * 256;
            for (int p = lo + tid; p < hi; p += NTHR) ROWTOK[p] = 0; }
        __syncthreads();
    }
}

typedef short bf16x8_t __attribute__((ext_vector_type(8)));
__device__ __forceinline__ void lds_barrier() { asm volatile("s_waitcnt lgkmcnt(0)" ::: "memory"); __builtin_amdgcn_s_barrier(); asm volatile("" ::: "memory"); }
__device__ __forceinline__ LAS unsigned char* vbase(LAS unsigned char* p) { unsigned a = (unsigned)(size_t)p; asm volatile("" : "+v"(a)); return (LAS unsigned char*)(size_t)a; }
constexpr int CH = 64, NCHUNK = SEQ / CH;

template <int DK, int DV, bool HAS_AB, bool BSK = false> struct Blob {
    static constexpr int ABAR = 0;
    static constexpr int MBAR = ABAR + (HAS_AB ? 64 * DK * 2 : 0);
    static constexpr int BDT = MBAR + (HAS_AB ? 64 * 64 * 2 : 0);
    static constexpr int NRB = BDT + ((HAS_AB && !BSK) ? DK * 64 * 2 : 0);
    static constexpr int KDT = NRB + ((HAS_AB && !BSK) ? 64 * 64 * 2 : 0);
    static constexpr int VT = KDT + DK * 64 * 2;
    static constexpr int RT = VT + DV * 64 * 2;
    static constexpr int NRK = RT + 64 * DK * 2;
    static constexpr int SVEC = NRK + 64 * 64 * 2;
    static constexpr int BYTES = SVEC + (BSK ? 256 : 0);
};
typedef Blob<64, 64, true> BlobW;
typedef Blob<128, 128, true, true> BlobG;
typedef Blob<128, 128, false> BlobR;

__device__ __forceinline__ void mm16(f32x4& acc, const LAS bf16* A, int sa, int m0, const LAS bf16* B, int sb, int n0, int K, int lane) {
    const int fr = lane & 15, fq = lane >> 4;
    const LAS bf16* pa = A + (m0 + fr) * sa + fq * 8; const LAS bf16* pb = B + (n0 + fr) * sb + fq * 8;
    for (int k = 0; k < K; k += 32) { const bf16x8_t a = *(const LAS bf16x8_t*)(pa + k); const bf16x8_t b = *(const LAS bf16x8_t*)(pb + k);
        acc = __builtin_amdgcn_mfma_f32_16x16x32_bf16(a, b, acc, 0, 0, 0); }
}
__device__ __forceinline__ v2u pack4(f32x4 v) { v2u o; o.x = pk2h(v[0], v[1]); o.y = pk2h(v[2], v[3]); return o; }

template <int ROWS, int LEN8> __device__ __forceinline__ void img_out(unsigned char* g, const LAS unsigned char* l, int sb, int tid) {
#pragma unroll
    for (int q = 0; q < (ROWS * LEN8 + NTHR - 1) / NTHR; ++q) { const int p = tid + NTHR * q; if (p < ROWS * LEN8) { const int row = p / LEN8, c = p % LEN8; *(v4u*)(g + (size_t)p * 16) = *(const LAS v4u*)(l + row * sb + c * 16); } }
}
template <int ROWS, int LEN8> struct ImgPref {
    static constexpr int NP = (ROWS * LEN8 + NTHR - 1) / NTHR;
    v4u r[NP];
    __device__ __forceinline__ void load(const unsigned char* g, int tid) {
#pragma unroll
        for (int q = 0; q < NP; ++q) { int p = tid + NTHR * q; if (ROWS * LEN8 % NTHR != 0) p = (p < ROWS * LEN8) ? p : 0; r[q] = *(const v4u*)(g + (size_t)p * 16); } }
    __device__ __forceinline__ void store(LAS unsigned char* l, int sb, int tid) const {
#pragma unroll
        for (int q = 0; q < NP; ++q) { const int p = tid + NTHR * q; if (p < ROWS * LEN8) { const int row = p / LEN8, c = p % LEN8; *(LAS v4u*)(l + row * sb + c * 16) = r[q]; } } }
};

__device__ __forceinline__ v4u pack8(const float (&v)[8]) { v4u o; o.x = pk2h(v[0], v[1]); o.y = pk2h(v[2], v[3]); o.z = pk2h(v[4], v[5]); o.w = pk2h(v[6], v[7]); return o; }
template <int DK, int DV, bool HAS_AB, bool PERCH, bool BSK, bool TCON  >
__device__ __forceinline__ void chunkA_rest(const float (&rA)[8][DK / 64], const float (&rB)[8][DK / 64], const float (&rK)[8][DK / 64], const float (&rR)[8][DK / 64],
                                            const float (&rV)[8][DV / 64], const float (&rLW)[8][DK / 64], const float (&rSV)[8], unsigned char* blob, float* pcg, LAS unsigned char* lds, int tid) {
    typedef Blob<DK, DV, HAS_AB, BSK> BL; static_assert(!BSK || (HAS_AB && !PERCH), "BSK is a scalar-decay mode");
    constexpr bool HAS_B = HAS_AB && !BSK;
    constexpr int NCH = DK / 64, NVC = DV / 64, SK = DK + 8, SC = 72, SKB = SK * 2, SCB = SC * 2;
    constexpr int LPB = PERCH ? 64 * DK * 4 : 512;
    constexpr int U0 = LPB;
    constexpr int O_BDT = U0, O_KDT = O_BDT + (HAS_B ? DK * SCB : 0), O_VT = O_KDT + DK * SCB;
    constexpr int STG_END = O_VT + DV * SCB;
    constexpr int R2_BYTES = (HAS_AB ? 64 * SKB : 0) + (HAS_B ? 64 * SKB : 0) + 2 * 64 * SKB + (HAS_AB ? DK * SCB + 2 * 64 * SCB + 64 * 68 * 4 + 64 * 20 * 4 : 0);
    constexpr bool UNALIAS = STG_END + R2_BYTES <= RING_BYTES;
    constexpr int O_IA = UNALIAS ? STG_END : U0, O_IB = O_IA + (HAS_AB ? 64 * SKB : 0), O_IK = O_IB + (HAS_B ? 64 * SKB : 0), O_IR = O_IK + 64 * SKB, O_IAT = O_IR + 64 * SKB,
                  O_IMT = O_IAT + (HAS_AB ? DK * SCB : 0), O_IT = O_IMT + (HAS_AB ? 64 * SCB : 0), O_MAB = O_IT + (HAS_AB ? 64 * SCB : 0), O_XB = O_MAB + (HAS_AB ? 64 * 68 * 4 : 0), O_END = O_XB + (HAS_AB ? 64 * 20 * 4 : 0);
    static_assert(O_END <= RING_BYTES && O_VT + DV * SCB <= RING_BYTES, "phase A LDS map");
    const int lane = tid & 63, wave = __builtin_amdgcn_readfirstlane(tid >> 6);
    LAS float* LP = (LAS float*)vbase(lds);
    LAS unsigned char* const bBDT = vbase(lds + O_BDT); LAS unsigned char* const bKDT = vbase(lds + O_KDT); LAS unsigned char* const bVT = vbase(lds + O_VT);
    LAS unsigned char* const bIA = vbase(lds + O_IA); LAS unsigned char* const bIB = vbase(lds + O_IB); LAS unsigned char* const bIK = vbase(lds + O_IK); LAS unsigned char* const bIR = vbase(lds + O_IR);
    LAS unsigned char* const bIAT = vbase(lds + O_IAT); LAS unsigned char* const bIMT = vbase(lds + O_IMT); LAS unsigned char* const bIT = vbase(lds + O_IT); LAS unsigned char* const bMAB = vbase(lds + O_MAB); LAS unsigned char* const bXB = vbase(lds + O_XB);
    float eP[8][NCH], eN[8][NCH], eA[8][NCH], eD[8][NCH];
    if (PERCH) {
        static_assert(!PERCH || TCON, "the per-channel scan assumes consecutive tokens per wave");
        float pre[8][NCH];
#pragma unroll
        for (int q = 0; q < NCH; ++q) { float s = 0.f;
#pragma unroll
            for (int j = 0; j < 8; ++j) { s += rLW[j][q]; pre[j][q] = s; }
            LP[wave * DK + lane + 64 * q] = s; }
        lds_barrier();
#pragma unroll
        for (int q = 0; q < NCH; ++q) { const int c = lane + 64 * q; float off = 0.f, lpc = 0.f;
#pragma unroll
            for (int w = 0; w < 8; ++w) { const float tw = LP[w * DK + c]; lpc += tw; off += (w < wave) ? tw : 0.f; }
            if (wave == 7) pcg[c] = __expf(lpc);
#pragma unroll
            for (int j = 0; j < 8; ++j) { const float lp = off + pre[j][q], lpm = (j > 0) ? off + pre[j - 1][q] : off;
                eP[j][q] = __expf(lp); eN[j][q] = __expf(-lp); eA[j][q] = __expf(lpm); eD[j][q] = __expf(lpc - lp); } }
    } else {
        if (lane == 0) {
#pragma unroll
            for (int j = 0; j < 8; ++j) { const int t = TCON ? 8 * wave + j : wave + 8 * j; LP[t] = rLW[j][0]; if (BSK) LP[64 + t] = rSV[j]; } }
        lds_barrier();
        if (wave == 0) { float sc = LP[lane];
#define SCAN_SHR(ctl) sc += __builtin_bit_cast(float, __builtin_amdgcn_update_dpp(0, __builtin_bit_cast(int, sc), ctl, 0xf, 0xf, true))
            SCAN_SHR(0x111); SCAN_SHR(0x112); SCAN_SHR(0x114); SCAN_SHR(0x118);
#undef SCAN_SHR
            sc += __builtin_bit_cast(float, __builtin_amdgcn_update_dpp(0, __builtin_bit_cast(int, sc), 0x142, 0xa, 0xf, false));
            sc += __builtin_bit_cast(float, __builtin_amdgcn_update_dpp(0, __builtin_bit_cast(int, sc), 0x143, 0xc, 0xf, false));
            LP[lane] = sc; }
        lds_barrier();
#pragma unroll
        for (int q = 0; q < NCH; ++q) { const int c = lane + 64 * q; const float lpc = LP[63];
            if (wave == 7) pcg[c] = __expf(lpc);
#pragma unroll
            for (int j = 0; j < 8; ++j) { const int t = TCON ? 8 * wave + j : wave + 8 * j;
                const float lp = LP[t], lpm = (t > 0) ? LP[t - 1] : 0.f;
                eP[j][q] = __expf(lp); eN[j][q] = 1.f; eA[j][q] = __expf(lpm); eD[j][q] = __expf(lpc - lp); } }
    }
    if (TCON) {
#pragma unroll
        for (int q = 0; q < NCH; ++q) { const int c = lane + 64 * q; float tb[8], tk[8];
#pragma unroll
            for (int j = 0; j < 8; ++j) { tb[j] = rB[j][q] * eD[j][q]; tk[j] = rK[j][q] * eD[j][q];
                *(bf16*)(blob + BL::RT + (size_t)((8 * wave + j) * DK + c) * 2) = (bf16)f2bfh(rR[j][q] * eP[j][q]); }
            if (HAS_B) *(LAS v4u*)(bBDT + c * SCB + 16 * wave) = pack8(tb);
            *(LAS v4u*)(bKDT + c * SCB + 16 * wave) = pack8(tk); }
#pragma unroll
        for (int q = 0; q < NVC; ++q) { float tv[8];
#pragma unroll
            for (int j = 0; j < 8; ++j) tv[j] = rV[j][q];
            *(LAS v4u*)(bVT + (lane + 64 * q) * SCB + 16 * wave) = pack8(tv); }
    } else {
#pragma unroll
    for (int j = 0; j < 8; ++j) { const int t = wave + 8 * j;
#pragma unroll
        for (int q = 0; q < NCH; ++q) { const int c = lane + 64 * q;
            if (HAS_B) *(LAS bf16*)(bBDT + c * SCB + t * 2) = (bf16)f2bfh(rB[j][q] * eD[j][q]);
            *(LAS bf16*)(bKDT + c * SCB + t * 2) = (bf16)f2bfh(rK[j][q] * eD[j][q]);
            *(bf16*)(blob + BL::RT + (size_t)(t * DK + c) * 2) = (bf16)f2bfh(rR[j][q] * eP[j][q]); }
#pragma unroll
        for (int q = 0; q < NVC; ++q) *(LAS bf16*)(bVT + (lane + 64 * q) * SCB + t * 2) = (bf16)f2bfh(rV[j][q]); }
    }
    if (!UNALIAS) { lds_barrier();
        if (HAS_B) img_out<DK, 8>(blob + BL::BDT, bBDT, SCB, tid);
        if (BSK && tid < 64) *(float*)(blob + BL::SVEC + tid * 4) = LP[64 + tid];
        img_out<DK, 8>(blob + BL::KDT, bKDT, SCB, tid);
        img_out<DV, 8>(blob + BL::VT, bVT, SCB, tid);
        lds_barrier(); }
#pragma unroll
    for (int q = 0; q < NCH; ++q) { const int c = lane + 64 * q; float ta[8];
#pragma unroll
        for (int j = 0; j < 8; ++j) { const int t = TCON ? 8 * wave + j : wave + 8 * j;
            const float ea = eA[j][q], en = eN[j][q], ep = PERCH ? eP[j][q] : 1.f;
            ta[j] = rA[j][q] * ea;
            if (HAS_AB) { *(LAS bf16*)(bIA + t * SKB + c * 2) = (bf16)f2bfh(PERCH ? ta[j] : rA[j][q]);
                if (HAS_B) *(LAS bf16*)(bIB + t * SKB + c * 2) = (bf16)f2bfh(rB[j][q] * en);
                if (!TCON) *(LAS bf16*)(bIAT + c * SCB + t * 2) = (bf16)f2bfh(ta[j]); }
            *(LAS bf16*)(bIK + t * SKB + c * 2) = (bf16)f2bfh(rK[j][q] * en);
            *(LAS bf16*)(bIR + t * SKB + c * 2) = (bf16)f2bfh(rR[j][q] * ep); }
        if (HAS_AB && TCON) *(LAS v4u*)(bIAT + c * SCB + 16 * wave) = pack8(ta); }
    lds_barrier();
    if (UNALIAS) {
        if (HAS_B) img_out<DK, 8>(blob + BL::BDT, bBDT, SCB, tid);
        if (BSK && tid < 64) *(float*)(blob + BL::SVEC + tid * 4) = LP[64 + tid];
        img_out<DK, 8>(blob + BL::KDT, bKDT, SCB, tid);
        img_out<DV, 8>(blob + BL::VT, bVT, SCB, tid); }
    const int fr = lane & 15, fq = lane >> 4;
    const LAS bf16* IA = (const LAS bf16*)(bIA); const LAS bf16* IB = (const LAS bf16*)(bIB); const LAS bf16* IK = (const LAS bf16*)(bIK); const LAS bf16* IR = (const LAS bf16*)(bIR);
#define CA_TILE(prod, tile) do { const int mt = (tile) & 3, nt = (tile) >> 2; const int tt = nt * 16 + fr, jj0 = mt * 16 + 4 * fq; \
        if ((prod) == 2) { const int jp = tt; f32x4 acc = {0.f, 0.f, 0.f, 0.f}; mm16(acc, IA, SK, mt * 16, IK, SK, nt * 16, DK, lane); \
            _Pragma("unroll") for (int i = 0; i < 4; ++i) { const int jr = jj0 + i; float f; \
                if (PERCH) f = (jp < jr) ? 1.f : 0.f; else { const float lpm = (jr > 0) ? LP[jr - 1] : 0.f; f = (jp < jr) ? __expf(lpm - LP[jp]) : 0.f; } \
                acc[i] *= f; } \
            *(LAS v2u*)(bIMT + jp * SCB + jj0 * 2) = pack4(acc); } \
        else { float f_n[4], f_m[4]; \
            _Pragma("unroll") for (int i = 0; i < 4; ++i) { const int jj = jj0 + i; \
                if (PERCH) { f_n[i] = (jj <= tt) ? 1.f : 0.f; f_m[i] = (jj < tt) ? 1.f : 0.f; } \
                else { const float lpt = LP[tt], lpm = (tt > 0) ? LP[tt - 1] : 0.f, lpj = LP[jj]; \
                    f_n[i] = (jj <= tt) ? __expf(lpt - lpj) : 0.f; f_m[i] = (jj < tt) ? __expf(lpm - lpj) : 0.f; } } \
            if ((prod) == 0) { f32x4 acc = {0.f, 0.f, 0.f, 0.f}; mm16(acc, IK, SK, mt * 16, IR, SK, nt * 16, DK, lane); \
                _Pragma("unroll") for (int i = 0; i < 4; ++i) acc[i] *= f_n[i]; \
                *(v2u*)(blob + BL::NRK + (size_t)(tt * 64 + jj0) * 2) = pack4(acc); } \
            else if ((prod) == 1) { f32x4 acc = {0.f, 0.f, 0.f, 0.f}; mm16(acc, IB, SK, mt * 16, IR, SK, nt * 16, DK, lane); \
                _Pragma("unroll") for (int i = 0; i < 4; ++i) acc[i] *= f_n[i]; \
                *(v2u*)(blob + (HAS_B ? BL::NRB : 0) + (size_t)(tt * 64 + jj0) * 2) = pack4(acc); } \
            else { f32x4 acc = {0.f, 0.f, 0.f, 0.f}; mm16(acc, BSK ? IK : IB, SK, mt * 16, IA, SK, nt * 16, DK, lane); \
                _Pragma("unroll") for (int i = 0; i < 4; ++i) acc[i] *= f_m[i] * (BSK ? LP[64 + jj0 + i] : 1.f); \
                *(LAS f32x4*)(bMAB + (tt * 68 + jj0) * 4) = acc; } } } while (0)
    if (!HAS_AB) {
#pragma unroll
        for (int rep = 0; rep < 2; ++rep) CA_TILE(0, wave + 8 * rep);
    } else {
#pragma unroll
        for (int rep = 0; rep < 2; ++rep) CA_TILE(3, wave + 8 * rep);
    }
    if (HAS_AB) {
        lds_barrier();
        LAS float* const MAB = (LAS float*)(bMAB); LAS float* const XB = (LAS float*)(bXB);
        if (wave != 0) { constexpr int NIT = HAS_B ? 48 : 32;
#pragma unroll
            for (int k = 0; k < (NIT + 6) / 7; ++k) { const int w = wave - 1 + 7 * k;
                if (w < NIT) { const int pr = w >> 4, tile = w & 15;
                    if (pr == 0) CA_TILE(0, tile); else if (HAS_B && pr == 1) CA_TILE(1, tile); else CA_TILE(2, tile); } } }
        if (wave == 0) { const int blk = lane >> 4, col = lane & 15; LAS float* Mb = MAB + (16 * blk) * 68 + 16 * blk; float x[16];
#pragma unroll
            for (int r = 0; r < 16; ++r) x[r] = 0.f;
#pragma unroll
            for (int r = 0; r < 16; ++r) { float a0 = (r == col) ? 1.f : 0.f, a1 = 0.f;
#pragma unroll
                for (int s4 = 0; s4 < r; s4 += 4) { const f32x4 mm = *(const LAS f32x4*)(Mb + r * 68 + s4);
                    a0 += mm[0] * x[s4] + mm[2] * x[s4 + 2]; a1 += mm[1] * x[s4 + 1] + mm[3] * x[s4 + 3]; }
                x[r] = a0 + a1; }
            asm volatile("s_waitcnt lgkmcnt(0)" ::: "memory");
#pragma unroll
            for (int r = 0; r < 16; ++r) Mb[r * 68 + col] = x[r]; }
        lds_barrier();
        { const int fr_ = lane & 15, fq_ = lane >> 4;
#define INV_MT(acc_, a_, s_, jt_) do { const int k0_ = 16 * (s_); const f32x4 av_ = *(const LAS f32x4*)(MAB + (16 * (a_) + fr_) * 68 + k0_ + 4 * fq_); \
            const float b0_ = MAB[(k0_ + 4 * fq_ + 0) * 68 + 16 * (jt_) + fr_], b1_ = MAB[(k0_ + 4 * fq_ + 1) * 68 + 16 * (jt_) + fr_], b2_ = MAB[(k0_ + 4 * fq_ + 2) * 68 + 16 * (jt_) + fr_], b3_ = MAB[(k0_ + 4 * fq_ + 3) * 68 + 16 * (jt_) + fr_]; \
            acc_ = __builtin_amdgcn_mfma_f32_16x16x4f32(av_[0], b0_, acc_, 0, 0, 0); acc_ = __builtin_amdgcn_mfma_f32_16x16x4f32(av_[1], b1_, acc_, 0, 0, 0); \
            acc_ = __builtin_amdgcn_mfma_f32_16x16x4f32(av_[2], b2_, acc_, 0, 0, 0); acc_ = __builtin_amdgcn_mfma_f32_16x16x4f32(av_[3], b3_, acc_, 0, 0, 0); } while (0)
#define INV_TX(acc_, a_, s_, xrow_, xcol_) do { const f32x4 av_ = *(const LAS f32x4*)(MAB + (16 * (a_) + fr_) * 68 + 16 * (s_) + 4 * fq_); const f32x4 bv_ = *(const LAS f32x4*)(XB + ((xrow_) + fr_) * 36 + (xcol_) + 4 * fq_); \
            acc_ = __builtin_amdgcn_mfma_f32_16x16x4f32(av_[0], bv_[0], acc_, 0, 0, 0); acc_ = __builtin_amdgcn_mfma_f32_16x16x4f32(av_[1], bv_[1], acc_, 0, 0, 0); \
            acc_ = __builtin_amdgcn_mfma_f32_16x16x4f32(av_[2], bv_[2], acc_, 0, 0, 0); acc_ = __builtin_amdgcn_mfma_f32_16x16x4f32(av_[3], bv_[3], acc_, 0, 0, 0); } while (0)
            if (wave < 2) { const int a = 1 + 2 * wave, jt = 2 * wave; f32x4 acc = {0.f, 0.f, 0.f, 0.f}; INV_MT(acc, a, jt, jt);
                *(LAS f32x4*)(XB + (16 * wave + fr_) * 36 + 4 * fq_) = acc; }
            lds_barrier();
            if (wave < 2) { const int a = 1 + 2 * wave, jt = 2 * wave; f32x4 acc = {0.f, 0.f, 0.f, 0.f}; INV_TX(acc, a, a, 16 * wave, 0);
#pragma unroll
                for (int i = 0; i < 4; ++i) MAB[(16 * a + 4 * fq_ + i) * 68 + 16 * jt + fr_] = acc[i]; }
            lds_barrier();
            if (wave < 4) { const int a = 2 + (wave >> 1), jt = wave & 1; f32x4 acc = {0.f, 0.f, 0.f, 0.f}; INV_MT(acc, a, 0, jt); INV_MT(acc, a, 1, jt);
                *(LAS f32x4*)(XB + (16 * jt + fr_) * 36 + 16 * (a - 2) + 4 * fq_) = acc; }
            lds_barrier();
            if (wave < 4) { const int a = 2 + (wave >> 1), jt = wave & 1; f32x4 acc = {0.f, 0.f, 0.f, 0.f}; INV_TX(acc, a, 2, 16 * jt, 0); INV_TX(acc, a, 3, 16 * jt, 16);
#pragma unroll
                for (int i = 0; i < 4; ++i) MAB[(16 * a + 4 * fq_ + i) * 68 + 16 * jt + fr_] = acc[i]; }
            lds_barrier();
#undef INV_MT
#undef INV_TX
        }
#pragma unroll
        for (int q = 0; q < 8; ++q) { const int e = tid + NTHR * q, t = e >> 6, j = e & 63; *(LAS bf16*)(bIT + t * SCB + j * 2) = (bf16)f2bfh(MAB[t * 68 + j]); }
        lds_barrier();
        const LAS bf16* IAT = (const LAS bf16*)(bIAT); const LAS bf16* IMT = (const LAS bf16*)(bIMT); const LAS bf16* IT = (const LAS bf16*)(bIT);
#pragma unroll
        for (int rep = 0; rep < DK / 32; ++rep) { const int tile = wave + 8 * rep, mt = tile % (DK / 16), nt = tile / (DK / 16);
            f32x4 acc = {0.f, 0.f, 0.f, 0.f}; mm16(acc, IAT, SC, mt * 16, IT, SC, nt * 16, 64, lane);
            *(v2u*)(blob + BL::ABAR + (size_t)((nt * 16 + fr) * DK + mt * 16 + 4 * fq) * 2) = pack4(acc); }
#pragma unroll
        for (int rep = 0; rep < 2; ++rep) { const int tile = wave + 8 * rep, mt = tile & 3, nt = tile >> 2;
            f32x4 acc = {0.f, 0.f, 0.f, 0.f}; mm16(acc, IMT, SC, mt * 16, IT, SC, nt * 16, 64, lane);
            *(v2u*)(blob + BL::MBAR + (size_t)((nt * 16 + fr) * 64 + mt * 16 + 4 * fq) * 2) = pack4(acc); }
    }
    lds_barrier();
}

struct RwkvIn { unsigned xr[9], xk[9], xv[9], xlw[8], xla[8], xlv[8]; float xvf[8]; };
__device__ __forceinline__ void rwkv_load(CArgs Ap, int l, int u, RwkvIn& X) {
    const int tid = otid(), lane = tid & 63, wave = __builtin_amdgcn_readfirstlane(tid >> 6);
    const int bh = u >> 5, chunk = u & 31, b = bh / 12, h = bh % 12, ch = h * 64 + lane;
    const bf16* PROJ = (const bf16*)(Ap->ws + WS_PROJ); const bf16* LR = (const bf16*)(Ap->ws + WS_LR); const float* VF = (const float*)(Ap->ws + WS_VF);
    const int tt0 = chunk * 64 + 8 * wave; const size_t m0 = (size_t)b * SEQ + tt0;
#pragma unroll
    for (int i = 0; i < 9; ++i) { const bool ok = (tt0 + i - 1) >= 0; const bf16* P = PROJ + (ok ? (m0 + i - 1) : m0) * NP;
        X.xr[i] = P[C_RR + ch]; X.xk[i] = P[C_RK + ch]; X.xv[i] = P[C_RV + ch]; }
#pragma unroll
    for (int j = 0; j < 8; ++j) { const size_t m = m0 + j; const bf16* L = LR + m * NLR;
        X.xlw[j] = L[ch]; X.xla[j] = L[768 + ch]; X.xlv[j] = (l > 0) ? (unsigned)L[1536 + ch] : 0u; X.xvf[j] = (l > 0) ? VF[m * 768 + ch] : 0.f; }
}
__device__ __forceinline__ void chunkA_rwkv(CArgs Ap, int l, int u, int un, RwkvIn& X, LAS unsigned char* lds) {
    const int tid = otid(), lane = tid & 63, wave = __builtin_amdgcn_readfirstlane(tid >> 6);
    const int bh = u >> 5, chunk = u & 31, b = bh / 12, h = bh % 12, ch = h * 64 + lane;
    float* VF = (float*)(Ap->ws + WS_VF); float* BON = (float*)(Ap->ws + WS_BON);
    const float mu_r = INF(I_MU_RKVG)[(l * 4 + 0) * 768 + ch], mu_k = INF(I_MU_RKVG)[(l * 4 + 1) * 768 + ch], mu_v = INF(I_MU_RKVG)[(l * 4 + 2) * 768 + ch];
    const float w0 = INF(I_W0)[l * 768 + ch], a0 = INF(I_A0)[l * 768 + ch], kkc = INF(I_KK)[l * 768 + ch], kac = INF(I_KA)[l * 768 + ch], rkc = INF(I_RK)[l * 768 + ch];
    const float v0c = (l > 0) ? INF(I_V0)[ch] : 0.f;
    float rA[8][1], rB[8][1], rK[8][1], rR[8][1], rV[8][1], rLW[8][1];
    const int tt0 = chunk * 64 + 8 * wave; const size_t m0 = (size_t)b * SEQ + tt0;
    float xr[9], xk[9], xv[9];
#pragma unroll
    for (int i = 0; i < 9; ++i) { const float mk = ((tt0 + i - 1) >= 0) ? 1.f : 0.f; xr[i] = mk * bf2f((bf16)X.xr[i]); xk[i] = mk * bf2f((bf16)X.xk[i]); xv[i] = mk * bf2f((bf16)X.xv[i]); }
#pragma unroll
    for (int j = 0; j < 8; ++j) { const size_t m = m0 + j;
        const float r = xr[j + 1] + (xr[j] - xr[j + 1]) * mu_r, k = xk[j + 1] + (xk[j] - xk[j + 1]) * mu_k; float v = xv[j + 1] + (xv[j] - xv[j + 1]) * mu_v;
        const float lw = -0.6065306597126334f * sigmoidf_(w0 + bf2f((bf16)X.xlw[j]));
        const float a = sigmoidf_(a0 + bf2f((bf16)X.xla[j]));
        if (l == 0) VF[m * 768 + ch] = v; else v = v + (X.xvf[j] - v) * sigmoidf_(v0c + bf2f((bf16)X.xlv[j]));
        const float kkr = k * kkc; const float kk = kkr * rsqrtf(wave_sum(kkr * kkr) + 1e-6f);
        const float k2 = k * (1.0f + (a - 1.0f) * kac);
        const float bon = wave_sum(r * k2 * rkc);
        if (lane == 0) BON[m * 12 + h] = bon;
        rA[j][0] = -kk; rB[j][0] = kk * a; rK[j][0] = k2; rR[j][0] = r; rV[j][0] = v; rLW[j][0] = lw; }
    rwkv_load(Ap, l, un, X);
    const float rSV[8] = {0.f, 0.f, 0.f, 0.f, 0.f, 0.f, 0.f, 0.f};
    chunkA_rest<64, 64, true, true, false, true>(rA, rB, rK, rR, rV, rLW, rSV, Ap->ws + WS_BLOBW + (size_t)u * BlobW::BYTES, (float*)(Ap->ws + WS_PCS) + (size_t)u * 64, lds, tid);
}
__device__ __forceinline__ void chunkA_gdn(CArgs Ap, int l, int u, LAS unsigned char* lds) {
    const int tid = otid(), lane = tid & 63, wave = __builtin_amdgcn_readfirstlane(tid >> 6);
    const int bh = u >> 5, chunk = u & 31, b = bh / 6, h = bh % 6;
    const bf16* PROJ = (const bf16*)(Ap->ws + WS_PROJ);
    const float* cw = INF(I_CONVW) + (size_t)l * 4 * 2304;
    const int cq0 = h * 128 + lane, cq1 = cq0 + 64, ck0 = 768 + cq0, ck1 = 768 + cq1, cv0 = 1536 + cq0, cv1 = 1536 + cq1;
    float wq0[4], wq1[4], wk0[4], wk1[4], wv0[4], wv1[4];
#pragma unroll
    for (int j = 0; j < 4; ++j) { wq0[j] = cw[j * 2304 + cq0]; wq1[j] = cw[j * 2304 + cq1]; wk0[j] = cw[j * 2304 + ck0]; wk1[j] = cw[j * 2304 + ck1]; wv0[j] = cw[j * 2304 + cv0]; wv1[j] = cw[j * 2304 + cv1]; }
    const float Aneg = -__expf(INF(I_ALOG)[l * 6 + h]), dtb = INF(I_DTB)[l * 6 + h];
    float rA[8][2], rB[8][2], rK[8][2], rR[8][2], rV[8][2], rLW[8][2], rSV[8];
    {
        const int tt0 = chunk * 64 + 8 * wave; const size_t m0 = (size_t)b * SEQ + tt0;
        float xq[11][2], xk[11][2], xv[11][2], xda[8], xdb[8];
#pragma unroll
        for (int i = 0; i < 11; ++i) { const bool ok = (tt0 + i - 3) >= 0; const float mk = ok ? 1.f : 0.f; const bf16* P = PROJ + (ok ? (m0 + i - 3) : m0) * NP + C_DQ;
            xq[i][0] = mk * bf2f(P[cq0]); xq[i][1] = mk * bf2f(P[cq1]); xk[i][0] = mk * bf2f(P[ck0]); xk[i][1] = mk * bf2f(P[ck1]); xv[i][0] = mk * bf2f(P[cv0]); xv[i][1] = mk * bf2f(P[cv1]); }
#pragma unroll
        for (int j = 0; j < 8; ++j) { const bf16* P = PROJ + (m0 + j) * NP; xda[j] = bf2f(P[C_DA + h]); xdb[j] = bf2f(P[C_DB + h]); }
#pragma unroll
        for (int j = 0; j < 8; ++j) {
            float q0 = 0.f, q1 = 0.f, k0 = 0.f, k1 = 0.f, v0 = 0.f, v1 = 0.f;
#pragma unroll
            for (int jj = 0; jj < 4; ++jj) { q0 += wq0[jj] * xq[j + jj][0]; q1 += wq1[jj] * xq[j + jj][1]; k0 += wk0[jj] * xk[j + jj][0]; k1 += wk1[jj] * xk[j + jj][1]; v0 += wv0[jj] * xv[j + jj][0]; v1 += wv1[jj] * xv[j + jj][1]; }
            q0 = siluf_(q0); q1 = siluf_(q1); k0 = siluf_(k0); k1 = siluf_(k1); v0 = siluf_(v0); v1 = siluf_(v1);
            const float qs = rsqrtf(wave_sum(q0 * q0 + q1 * q1) + 1e-6f) * 0.08838834764831845f, ksn = rsqrtf(wave_sum(k0 * k0 + k1 * k1) + 1e-6f);
            k0 *= ksn; k1 *= ksn;
            const float x = xda[j] + dtb; const float sp = (x > 20.f) ? x : __logf(1.0f + __expf(x));
            const float g = Aneg * sp, al = __expf(g), be = sigmoidf_(xdb[j]);
            rA[j][0] = k0; rA[j][1] = k1; rB[j][0] = -al * be * k0; rB[j][1] = -al * be * k1; rK[j][0] = k0; rK[j][1] = k1; rR[j][0] = q0 * qs; rR[j][1] = q1 * qs;
            rV[j][0] = be * v0; rV[j][1] = be * v1; rLW[j][0] = g; rLW[j][1] = g; rSV[j] = -al * be; } }
    chunkA_rest<128, 128, true, false, true, true>(rA, rB, rK, rR, rV, rLW, rSV, Ap->ws + WS_BLOBG + (size_t)u * BlobG::BYTES, (float*)(Ap->ws + WS_PCS) + 1536 * 64 + (size_t)u * 128, lds, tid);
}
__device__ __forceinline__ void chunkA_ret(CArgs Ap, int l, int u, LAS unsigned char* lds) {
    const int tid = otid(), lane = tid & 63, wave = __builtin_amdgcn_readfirstlane(tid >> 6);
    const int bh = u >> 5, chunk = u & 31, b = bh / 4, h = bh % 4;
    const bf16* PROJ = (const bf16*)(Ap->ws + WS_PROJ); const int* POSI = (const int*)Ap->in[I_POS];
    const double inv_freq = (double)exp2f(-(float)lane * (13.287712379549449f / 64.0f));
    const float lgam = __logf(1.0f - exp2f(-5.0f - (float)h));
    float rA[8][2], rB[8][2], rK[8][2], rR[8][2], rV[8][2], rLW[8][2];
#pragma unroll
    for (int j = 0; j < 8; ++j) { const int t = 8 * wave + j, tt = chunk * 64 + t; const size_t m = (size_t)b * SEQ + tt;
        const bf16* P = PROJ + m * NP;
        const double xd = (double)POSI[m] * inv_freq * 0.15915494309189535; const float fr = (float)(xd - __builtin_rint(xd));
        const float sn = __builtin_amdgcn_sinf(fr), cs = __builtin_amdgcn_cosf(fr);
        const float q1 = bf2f(P[C_TQ + h * 128 + lane]), q2 = bf2f(P[C_TQ + h * 128 + 64 + lane]);
        const float k1 = bf2f(P[C_TK + h * 128 + lane]) * 0.08838834764831845f, k2 = bf2f(P[C_TK + h * 128 + 64 + lane]) * 0.08838834764831845f;
        rR[j][0] = q1 * cs - q2 * sn; rR[j][1] = q1 * sn + q2 * cs; rK[j][0] = k1 * cs - k2 * sn; rK[j][1] = k1 * sn + k2 * cs;
        rV[j][0] = bf2f(P[C_TV + h * 128 + lane]); rV[j][1] = bf2f(P[C_TV + h * 128 + 64 + lane]);
        rA[j][0] = 0.f; rA[j][1] = 0.f; rB[j][0] = 0.f; rB[j][1] = 0.f; rLW[j][0] = lgam; rLW[j][1] = lgam; }
    const float rSV[8] = {0.f, 0.f, 0.f, 0.f, 0.f, 0.f, 0.f, 0.f};
    chunkA_rest<128, 128, false, false, false, true>(rA, rB, rK, rR, rV, rLW, rSV, Ap->ws + WS_BLOBR + (size_t)u * BlobR::BYTES, (float*)(Ap->ws + WS_PCS) + 1536 * 64 + 768 * 128 + (size_t)u * 128, lds, tid);
}
__device__ __forceinline__ void phase_mixA(CArgs Ap, int l, LAS unsigned char* lds) {
    for (int u = blockIdx.x; u < 768; u += gridDim.x) chunkA_gdn(Ap, l, u, lds);
    { RwkvIn X; const int u0 = blockIdx.x; if (u0 < 1536) rwkv_load(Ap, l, u0, X);
      for (int u = u0; u < 1536; u += gridDim.x) { const int un = (u + (int)gridDim.x < 1536) ? u + (int)gridDim.x : u; chunkA_rwkv(Ap, l, u, un, X, lds); } }
    for (int u = blockIdx.x; u < 512; u += gridDim.x) chunkA_ret(Ap, l, u, lds);
}

template <int DK, int DV, bool HAS_AB, int NS, bool BSK>
__device__ __forceinline__ void passB(const unsigned char* blob0, const float* pc0, int slice, bf16* oraw, LAS unsigned char* lds) {
    typedef Blob<DK, DV, HAS_AB, BSK> BL; constexpr bool HAS_B = HAS_AB && !BSK;
    constexpr int SK = DK + 8, SC = 72, SKB = SK * 2, SCB = SC * 2, NMT = DK / 16, NNT = NS / 16;
    constexpr int NST = NMT * NNT / 8, NUT = 4 * NNT / 8, NOT = NNT * 4 / 8;
    constexpr int O_ABAR = 0, O_MBAR = O_ABAR + (HAS_AB ? 64 * SKB : 0), O_BDT = O_MBAR + (HAS_AB ? 64 * SCB : 0), O_NRB = O_BDT + (HAS_B ? DK * SCB : 0), O_KDT = O_NRB + (HAS_B ? 64 * SCB : 0),
                  O_VT = O_KDT + DK * SCB, O_RT = O_VT + NS * SCB, O_NRK = O_RT + 64 * SKB, O_S0T = O_NRK + 64 * SCB, O_UT = O_S0T + NS * SKB, O_PC = O_UT + (HAS_AB ? NS * SCB : 0), O_SV = O_PC + DK * 4, O_END = O_SV + (BSK ? 256 : 0);
    static_assert(O_END <= MISC_OFF && NST >= 1 && NUT >= 1, "pass B LDS map / tiling");
    const int tid = otid(), lane = tid & 63, wave = __builtin_amdgcn_readfirstlane(tid >> 6), fr = lane & 15, fq = lane >> 4;
    LAS unsigned char* const qABAR = vbase(lds + O_ABAR); LAS unsigned char* const qMBAR = vbase(lds + O_MBAR); LAS unsigned char* const qBDT = vbase(lds + O_BDT); LAS unsigned char* const qNRB = vbase(lds + O_NRB); LAS unsigned char* const qKDT = vbase(lds + O_KDT); LAS unsigned char* const qVT = vbase(lds + O_VT); LAS unsigned char* const qRT = vbase(lds + O_RT); LAS unsigned char* const qNRK = vbase(lds + O_NRK); LAS unsigned char* const qS0T = vbase(lds + O_S0T); LAS unsigned char* const qUT = vbase(lds + O_UT); LAS unsigned char* const qPC = vbase(lds + O_PC); LAS unsigned char* const qSV = vbase(lds + O_SV);
    f32x4 S[NST];
#pragma unroll
    for (int i = 0; i < NST; ++i) S[i] = (f32x4){0.f, 0.f, 0.f, 0.f};
    ImgPref<64, DK / 8> pA_0, pA_1; ImgPref<64, 8> pM_0, pM_1; ImgPref<DK, 8> pBd_0, pBd_1; ImgPref<64, 8> pNb_0, pNb_1; ImgPref<DK, 8> pKd_0, pKd_1; ImgPref<NS, 8> pV_0, pV_1; ImgPref<64, DK / 8> pR_0, pR_1; ImgPref<64, 8> pNk_0, pNk_1;
    float pcr_0 = 0.f, pcr_1 = 0.f, svr_0 = 0.f, svr_1 = 0.f;
#define PB_LOAD(S, cn) do { const int cc_ = ((cn) < NCHUNK) ? (cn) : (NCHUNK - 1); const unsigned char* bl_ = blob0 + (size_t)cc_ * BL::BYTES; \
        if (HAS_AB) { pA_##S.load(bl_ + BL::ABAR, tid); pM_##S.load(bl_ + BL::MBAR, tid); } if (HAS_B) { pBd_##S.load(bl_ + BL::BDT, tid); pNb_##S.load(bl_ + BL::NRB, tid); } \
        if (BSK) svr_##S = *(const float*)(bl_ + BL::SVEC + (tid & 63) * 4); \
        pKd_##S.load(bl_ + BL::KDT, tid); pV_##S.load(bl_ + BL::VT + slice * NS * 128, tid); pR_##S.load(bl_ + BL::RT, tid); pNk_##S.load(bl_ + BL::NRK, tid); \
        pcr_##S = pc0[(size_t)cc_ * DK + (tid & (DK - 1))]; } while (0)
#define PB_STORE(S) do { if (HAS_AB) { pA_##S.store(qABAR, SKB, tid); pM_##S.store(qMBAR, SCB, tid); } if (HAS_B) { pBd_##S.store(qBDT, SCB, tid); pNb_##S.store(qNRB, SCB, tid); } \
        if (BSK && tid < 64) *(LAS float*)(qSV + tid * 4) = svr_##S; \
        pKd_##S.store(qKDT, SCB, tid); pV_##S.store(qVT, SCB, tid); pR_##S.store(qRT, SKB, tid); pNk_##S.store(qNRK, SCB, tid); \
        if (tid < DK) *(LAS float*)(qPC + tid * 4) = pcr_##S; } while (0)
    PB_LOAD(0, 0); PB_STORE(0); PB_LOAD(0, 1);
    const LAS bf16* ABARs = (const LAS bf16*)(qABAR); const LAS bf16* MBARs = (const LAS bf16*)(qMBAR); const LAS bf16* BDTs = (const LAS bf16*)(qBDT); const LAS bf16* NRBs = (const LAS bf16*)(qNRB);
    const LAS bf16* KDTs = (const LAS bf16*)(qKDT); const LAS bf16* VTs = (const LAS bf16*)(qVT); const LAS bf16* RTs = (const LAS bf16*)(qRT); const LAS bf16* NRKs = (const LAS bf16*)(qNRK);
    const LAS bf16* S0T = (const LAS bf16*)(qS0T); const LAS bf16* UT = (const LAS bf16*)(qUT);
#define PB_S0T() do { _Pragma("unroll") for (int i = 0; i < NST; ++i) { const int tile = wave + 8 * i, mt = tile % NMT, nt = tile / NMT; \
        *(LAS v2u*)(qS0T + (nt * 16 + fr) * SKB + (mt * 16 + 4 * fq) * 2) = pack4(S[i]); } } while (0)
#define PB_CHUNK(cn_) do { \
        f32x4 oacc[NOT]; \
        _Pragma("unroll") for (int i = 0; i < NOT; ++i) { const int tile = wave + 8 * i, mt2 = tile % NNT, nt2 = tile / NNT; oacc[i] = (f32x4){0.f, 0.f, 0.f, 0.f}; \
            mm16(oacc[i], S0T, SK, mt2 * 16, RTs, SK, nt2 * 16, DK, lane); \
            if (!BSK) mm16(oacc[i], VTs, SC, mt2 * 16, NRKs, SC, nt2 * 16, 64, lane); } \
        if (HAS_AB) { \
            _Pragma("unroll") for (int i = 0; i < NUT; ++i) { const int tile = wave + 8 * i, mt = tile & 3, nt = tile >> 2; f32x4 uacc = {0.f, 0.f, 0.f, 0.f}; \
                mm16(uacc, ABARs, SK, mt * 16, S0T, SK, nt * 16, DK, lane); \
                mm16(uacc, MBARs, SC, mt * 16, VTs, SC, nt * 16, 64, lane); \
                if (BSK) { const f32x4 sv = *(const LAS f32x4*)(qSV + (mt * 16 + 4 * fq) * 4); const v2u vv = *(const LAS v2u*)(qVT + (nt * 16 + fr) * SCB + (mt * 16 + 4 * fq) * 2); \
                    uacc[0] = sv[0] * uacc[0] + bf2f((bf16)(vv.x & 0xffff)); uacc[1] = sv[1] * uacc[1] + bf2f((bf16)(vv.x >> 16)); uacc[2] = sv[2] * uacc[2] + bf2f((bf16)(vv.y & 0xffff)); uacc[3] = sv[3] * uacc[3] + bf2f((bf16)(vv.y >> 16)); } \
                *(LAS v2u*)(qUT + (nt * 16 + fr) * SCB + (mt * 16 + 4 * fq) * 2) = pack4(uacc); } \
            lds_barrier(); \
            _Pragma("unroll") for (int i = 0; i < NOT; ++i) { const int tile = wave + 8 * i, mt2 = tile % NNT, nt2 = tile / NNT; mm16(oacc[i], UT, SC, mt2 * 16, BSK ? NRKs : NRBs, SC, nt2 * 16, 64, lane); } } \
        _Pragma("unroll") for (int i = 0; i < NOT; ++i) { const int tile = wave + 8 * i, mt2 = tile % NNT, nt2 = tile / NNT; \
            *(v2u*)(oraw + (size_t)((cn_) * 64 + nt2 * 16 + fr) * DM + mt2 * 16 + 4 * fq) = pack4(oacc[i]); } \
        _Pragma("unroll") for (int i = 0; i < NST; ++i) { const int tile = wave + 8 * i, mt = tile % NMT, nt = tile / NMT; \
            const f32x4 pc = *(const LAS f32x4*)(qPC + (mt * 16 + 4 * fq) * 4); \
            f32x4 s_ = S[i] * pc; \
            if (HAS_B) mm16(s_, BDTs, SC, mt * 16, UT, SC, nt * 16, 64, lane); \
            mm16(s_, KDTs, SC, mt * 16, BSK ? UT : VTs, SC, nt * 16, 64, lane); \
            S[i] = s_; } \
        lds_barrier(); } while (0)
    PB_S0T();
    lds_barrier();
#pragma unroll 1
    for (int cn = 0; cn < NCHUNK; cn += 2) {
        PB_LOAD(1, cn + 2); PB_CHUNK(cn);     PB_S0T(); PB_STORE(0); lds_barrier();
        PB_LOAD(0, cn + 3); PB_CHUNK(cn + 1); PB_S0T(); PB_STORE(1); lds_barrier();
    }
#undef PB_S0T
#undef PB_CHUNK
#undef PB_LOAD
#undef PB_STORE
}
template <int RB> __device__ __forceinline__ int swz_piece(int r, int p) { return RB == 128 ? (p ^ ((r >> 1) & 7)) : (p ^ (r & 15)); }
template <int RB, int NKB> __device__ __forceinline__ void dma_img(const unsigned char* g, LAS unsigned char* l, int wave, int lane) {
    static_assert(NKB % 8 == 0, "every wave issues the same number of DMA instructions");
#pragma unroll
    for (int q = 0; q < NKB / 8; ++q) { const int kb = wave + 8 * q; const int byte = kb * 1024 + lane * 16, r = byte / RB, ps = (byte % RB) / 16;
        __builtin_amdgcn_global_load_lds((const unsigned*)(g + r * RB + swz_piece<RB>(r, ps) * 16), (LAS unsigned*)(l + kb * 1024), 16, 0, 0); }
}
template <int N> __device__ __forceinline__ void wait_vm() {
    if (N == 3) asm volatile("s_waitcnt vmcnt(3)" ::: "memory"); else if (N == 6) asm volatile("s_waitcnt vmcnt(6)" ::: "memory"); else if (N == 8) asm volatile("s_waitcnt vmcnt(8)" ::: "memory"); else asm volatile("s_waitcnt vmcnt(0)" ::: "memory");
}
template <int DK, int DV, int NS, bool BSK>
__device__ __forceinline__ void passB3(const unsigned char* blob0, const float* pc0, int slice, bf16* oraw, LAS unsigned char* lds) {
    typedef Blob<DK, DV, true, BSK> BL; constexpr bool HAS_B = !BSK;
    constexpr int SK = DK + 8, SC = 72, SKB = SK * 2, SCB = SC * 2, NMT = DK / 16, NNT = NS / 16, NST = NMT * NNT / 8, KD = DK / 32, RBW = DK * 2;
    static_assert(NNT == 2 && 8 % NMT == 0 && NST >= 1 && (RBW == 128 || RBW == 256), "tiling");
    constexpr int B_A = 64 * RBW, B_M = 64 * 128, B_R = 64 * RBW, B_N = 64 * 128, B_K = DK * 128;
    constexpr int SZD = B_A + B_M + B_R + (HAS_B ? B_N : 0);
    constexpr int O_KDT = 2 * SZD, O_X1 = O_KDT + B_K  , O_X2 = O_X1 + (BSK ? B_N : B_K)  , O_VT = O_X2 + (HAS_B ? B_N : 0),
                  O_S0T = O_VT + NS * SCB, O_UT = O_S0T + NS * SKB, O_PC = O_UT + NS * SCB, O_SV = O_PC + DK * 4, O_END = O_SV + 256;
    static_assert(O_END <= MISC_OFF && SZD % 1024 == 0, "pass B LDS map");
    constexpr int ND = (B_A + B_M + B_R + (HAS_B ? B_N : 0)) / 8192, NSG = (B_K + (BSK ? B_N : B_K + B_N)) / 8192, NL = 2 + (BSK ? 1 : 0);
    const int tid = otid(), lane = tid & 63, wave = __builtin_amdgcn_readfirstlane(tid >> 6), fr = lane & 15, fq = lane >> 4;
    LAS unsigned char* const qD_0 = vbase(lds); LAS unsigned char* const qD_1 = vbase(lds + SZD);
    LAS unsigned char* const qKDT = vbase(lds + O_KDT); LAS unsigned char* const qX1 = vbase(lds + O_X1); LAS unsigned char* const qX2 = vbase(lds + O_X2);
    LAS unsigned char* const qVT = vbase(lds + O_VT); LAS unsigned char* const qS0T = vbase(lds + O_S0T); LAS unsigned char* const qUT = vbase(lds + O_UT); LAS unsigned char* const qPC = vbase(lds + O_PC); LAS unsigned char* const qSV = vbase(lds + O_SV);
    const int mtU = wave & 3, ntU = wave >> 2, mtO = wave % NNT, ntO = wave / NNT, mtS = wave % NMT;
    f32x4 S[NST];
#pragma unroll
    for (int i = 0; i < NST; ++i) S[i] = (f32x4){0.f, 0.f, 0.f, 0.f};
    ImgPref<NS, 8> pV_0, pV_1; float pcr_0 = 0.f, pcr_1 = 0.f, svr_0 = 0.f, svr_1 = 0.f;
#define DB_BLOB(cn) (blob0 + (size_t)(((cn) < NCHUNK) ? (cn) : (NCHUNK - 1)) * BL::BYTES)
#define DB_DMA_D(cn, P) do { const unsigned char* bl_ = DB_BLOB(cn); dma_img<RBW, B_A / 1024>(bl_ + BL::ABAR, qD_##P, wave, lane); dma_img<128, B_M / 1024>(bl_ + BL::MBAR, qD_##P + B_A, wave, lane); \
        dma_img<RBW, B_R / 1024>(bl_ + BL::RT, qD_##P + B_A + B_M, wave, lane); if (HAS_B) dma_img<128, B_N / 1024>(bl_ + BL::NRK, qD_##P + B_A + B_M + B_R, wave, lane); } while (0)
#define DB_DMA_S(cn) do { const unsigned char* bl_ = DB_BLOB(cn); dma_img<128, B_K / 1024>(bl_ + BL::KDT, qKDT, wave, lane); \
        if (BSK) dma_img<128, B_N / 1024>(bl_ + BL::NRK, qX1, wave, lane); else { dma_img<128, B_K / 1024>(bl_ + (HAS_B ? BL::BDT : 0), qX1, wave, lane); dma_img<128, B_N / 1024>(bl_ + (HAS_B ? BL::NRB : 0), qX2, wave, lane); } } while (0)
#define DB_VLOAD(S_, cn) do { const int cc_ = ((cn) < NCHUNK) ? (cn) : (NCHUNK - 1); const unsigned char* bl_ = blob0 + (size_t)cc_ * BL::BYTES; \
        pV_##S_.load(bl_ + BL::VT + slice * NS * 128, tid); pcr_##S_ = pc0[(size_t)cc_ * DK + (tid & (DK - 1))]; if (BSK) svr_##S_ = *(const float*)(bl_ + BL::SVEC + (tid & 63) * 4); } while (0)
#define DB_VSTORE(S_) do { pV_##S_.store(qVT, SCB, tid); if (tid < DK) *(LAS float*)(qPC + tid * 4) = pcr_##S_; if (BSK && tid < 64) *(LAS float*)(qSV + tid * 4) = svr_##S_; } while (0)
#define DB_S0T() do { _Pragma("unroll") for (int i = 0; i < NST; ++i) { const int tile = wave + 8 * i, mt = tile % NMT, nt = tile / NMT; \
        *(LAS v2u*)(qS0T + (nt * 16 + fr) * SKB + (mt * 16 + 4 * fq) * 2) = pack4(S[i]); } } while (0)
#define OPP(img, strideB, row0, kk) (*(const LAS bf16x8_t*)((img) + ((row0) + fr) * (strideB) + 16 * fq + 64 * (kk)))
#define OPS(RB_, img, row0, kk) (*(const LAS bf16x8_t*)((img) + ((row0) + fr) * (RB_) + swz_piece<RB_>((row0) + fr, 4 * (kk) + fq) * 16))
#define DB_CHUNK(cn_, P) do { LAS unsigned char* const dA = qD_##P; LAS unsigned char* const dM = dA + B_A; LAS unsigned char* const dR = dM + B_M; LAS unsigned char* const dN = HAS_B ? dR + B_R : qX1; \
        f32x4 oacc = {0.f, 0.f, 0.f, 0.f}, uacc = {0.f, 0.f, 0.f, 0.f}; \
        _Pragma("unroll") for (int k = 0; k < KD; ++k) oacc = __builtin_amdgcn_mfma_f32_16x16x32_bf16(OPP(qS0T, SKB, mtO * 16, k), OPS(RBW, dR, ntO * 16, k), oacc, 0, 0, 0); \
        if (!BSK) { _Pragma("unroll") for (int k = 0; k < 2; ++k) oacc = __builtin_amdgcn_mfma_f32_16x16x32_bf16(OPP(qVT, SCB, mtO * 16, k), OPS(128, dN, ntO * 16, k), oacc, 0, 0, 0); } \
        _Pragma("unroll") for (int k = 0; k < KD; ++k) uacc = __builtin_amdgcn_mfma_f32_16x16x32_bf16(OPS(RBW, dA, mtU * 16, k), OPP(qS0T, SKB, ntU * 16, k), uacc, 0, 0, 0); \
        _Pragma("unroll") for (int k = 0; k < 2; ++k) uacc = __builtin_amdgcn_mfma_f32_16x16x32_bf16(OPS(128, dM, mtU * 16, k), OPP(qVT, SCB, ntU * 16, k), uacc, 0, 0, 0); \
        if (BSK) { const f32x4 sv = *(const LAS f32x4*)(qSV + (mtU * 16 + 4 * fq) * 4); const v2u vv = *(const LAS v2u*)(qVT + (ntU * 16 + fr) * SCB + (mtU * 16 + 4 * fq) * 2); \
            uacc[0] = sv[0] * uacc[0] + bf2f((bf16)(vv.x & 0xffff)); uacc[1] = sv[1] * uacc[1] + bf2f((bf16)(vv.x >> 16)); uacc[2] = sv[2] * uacc[2] + bf2f((bf16)(vv.y & 0xffff)); uacc[3] = sv[3] * uacc[3] + bf2f((bf16)(vv.y >> 16)); } \
        *(LAS v2u*)(qUT + (ntU * 16 + fr) * SCB + (mtU * 16 + 4 * fq) * 2) = pack4(uacc); \
        wait_vm<ND + NL>(); lds_barrier();                                     \
        _Pragma("unroll") for (int k = 0; k < 2; ++k) oacc = __builtin_amdgcn_mfma_f32_16x16x32_bf16(OPP(qUT, SCB, mtO * 16, k), OPS(128, BSK ? qX1 : qX2, ntO * 16, k), oacc, 0, 0, 0); \
        *(v2u*)(oraw + (size_t)((cn_) * 64 + ntO * 16 + fr) * DM + mtO * 16 + 4 * fq) = pack4(oacc); \
        _Pragma("unroll") for (int i = 0; i < NST; ++i) { const int nt = (wave + 8 * i) / NMT; \
            const f32x4 pc = *(const LAS f32x4*)(qPC + (mtS * 16 + 4 * fq) * 4); \
            f32x4 s_ = S[i] * pc; \
            if (HAS_B) { _Pragma("unroll") for (int k = 0; k < 2; ++k) s_ = __builtin_amdgcn_mfma_f32_16x16x32_bf16(OPS(128, qX1, mtS * 16, k), OPP(qUT, SCB, nt * 16, k), s_, 0, 0, 0); } \
            _Pragma("unroll") for (int k = 0; k < 2; ++k) s_ = __builtin_amdgcn_mfma_f32_16x16x32_bf16(OPS(128, qKDT, mtS * 16, k), OPP(BSK ? qUT : qVT, SCB, nt * 16, k), s_, 0, 0, 0); \
            S[i] = s_; } \
        lds_barrier(); } while (0)
    static_assert(ND + NL == 8 || ND + NL == 6, "wait_vm cases"); static_assert(NSG == 3, "wait_vm cases");
    DB_DMA_D(0, 0); DB_DMA_S(0); DB_VLOAD(0, 0); asm volatile("s_waitcnt vmcnt(0)" ::: "memory"); DB_VSTORE(0); DB_VLOAD(0, 1);
    DB_S0T();
    lds_barrier();
#pragma unroll 1
    for (int cn = 0; cn < NCHUNK; cn += 2) {
        DB_DMA_D(cn + 1, 1); DB_VLOAD(1, cn + 2); DB_CHUNK(cn, 0);     DB_DMA_S(cn + 1); DB_S0T(); DB_VSTORE(0); wait_vm<NSG>(); lds_barrier();
        DB_DMA_D(cn + 2, 0); DB_VLOAD(0, cn + 3); DB_CHUNK(cn + 1, 1); DB_DMA_S(cn + 2); DB_S0T(); DB_VSTORE(1); wait_vm<NSG>(); lds_barrier();
    }
    asm volatile("s_waitcnt vmcnt(0)" ::: "memory");
    lds_barrier();
#undef DB_BLOB
#undef DB_DMA_D
#undef DB_DMA_S
#undef DB_VLOAD
#undef DB_VSTORE
#undef DB_S0T
#undef OPP
#undef OPS
#undef DB_CHUNK
}
__device__ __forceinline__ void phase_mixB(CArgs Ap, int l, LAS unsigned char* lds) {
    bf16* ORAW = (bf16*)(Ap->ws + WS_ORAW); const float* PCS = (const float*)(Ap->ws + WS_PCS);
    for (int u = blockIdx.x; u < 256; u += gridDim.x) {
        if (u < 96) { const int v = u, y = v >> 3, bh = (v & 7) + 8 * (y >> 1), slice = y & 1, b = bh / 12, h = bh % 12;
            passB<64, 64, true, 32, false>(Ap->ws + WS_BLOBW + (size_t)bh * 32 * BlobW::BYTES, PCS + (size_t)bh * 32 * 64, slice, ORAW + (size_t)b * SEQ * DM + h * 64 + slice * 32, lds); }
        else if (u < 192) { const int v = u - 96, y = v >> 3, bh = (v & 7) + 8 * (y >> 2), slice = y & 3, b = bh / 6, h = bh % 6;
            passB3<128, 128, 32, true>(Ap->ws + WS_BLOBG + (size_t)bh * 32 * BlobG::BYTES, PCS + 1536 * 64 + (size_t)bh * 32 * 128, slice, ORAW + (size_t)b * SEQ * DM + 1280 + h * 128 + slice * 32, lds); }
        else { const int v = u - 192, y = v >> 3, bh = (v & 7) + 8 * (y >> 2), slice = y & 3, b = bh / 4, h = bh % 4;
            passB<128, 128, false, 32, false>(Ap->ws + WS_BLOBR + (size_t)bh * 32 * BlobR::BYTES, PCS + 1536 * 64 + 768 * 128 + (size_t)bh * 32 * 128, slice, ORAW + (size_t)b * SEQ * DM + 768 + h * 128 + slice * 32, lds); }
    }
    if (gridDim.x == 256) { __syncthreads();
        if (blockIdx.x >= 192) convert_w2_pipe(Ap, l, lds, (int)blockIdx.x - 192, 64, 0, 8192); }
    else { __syncthreads(); phase_convert<2>(Ap, l, lds, (int)blockIdx.x, (int)gridDim.x); }
}

__device__ __forceinline__ void phase_m2c(CArgs Ap, int l) {
    const int wave = __builtin_amdgcn_readfirstlane(otid() >> 6);
    const int gw = blockIdx.x * NWAVES + wave, NGW = gridDim.x * NWAVES;
    const bf16* PROJ = (const bf16*)(Ap->ws + WS_PROJ); const bf16* ORAW = (const bf16*)(Ap->ws + WS_ORAW); bf16* MIX = (bf16*)(Ap->ws + WS_MIX);
    const bf16* LR = (const bf16*)(Ap->ws + WS_LR); const float* VF = (const float*)(Ap->ws + WS_VF); const float* BON = (const float*)(Ap->ws + WS_BON);
    for (int m = gw; m < NTOK; m += NGW) { const int lane = otid() & 63, hq = lane >> 4, sub = lane & 15;
        const bool hp = (m % SEQ) > 0; const float hpf = hp ? 1.f : 0.f;
        const bf16* P = PROJ + (size_t)m * NP; const bf16* Pp = hp ? P - NP : P; const bf16* O = ORAW + (size_t)m * DM; bf16* OUT = MIX + (size_t)m * DM;
#pragma unroll
        for (int grp = 0; grp < 3; ++grp) { const int h = 4 * grp + hq, ch0 = h * 64 + 4 * sub;
            float o[4], v0[4], g0[4], v1[4], g1[4], lrv[4] = {0.f, 0.f, 0.f, 0.f};
            unpk4(*(const v2u*)(O + ch0), o); unpk4(*(const v2u*)(P + C_RV + ch0), v0); unpk4(*(const v2u*)(P + C_RG + ch0), g0); unpk4(*(const v2u*)(Pp + C_RV + ch0), v1); unpk4(*(const v2u*)(Pp + C_RG + ch0), g1);
            const f32x4 muv = *(const f32x4*)(INF(I_MU_RKVG) + (l * 4 + 2) * 768 + ch0), mug = *(const f32x4*)(INF(I_MU_RKVG) + (l * 4 + 3) * 768 + ch0);
            const f32x4 lnw = *(const f32x4*)(INF(I_LNW) + l * 768 + ch0), lnb = *(const f32x4*)(INF(I_LNB) + l * 768 + ch0);
            f32x4 vf = {0.f, 0.f, 0.f, 0.f}, v0c = {0.f, 0.f, 0.f, 0.f};
            if (l > 0) { vf = *(const f32x4*)(VF + (size_t)m * 768 + ch0); v0c = *(const f32x4*)(INF(I_V0) + ch0); unpk4(*(const v2u*)(LR + (size_t)m * NLR + 1536 + ch0), lrv); }
            const float bn = BON[(size_t)m * 12 + h];
            float v[4], g[4], ssum = 0.f;
#pragma unroll
            for (int e = 0; e < 4; ++e) { v[e] = v0[e] + (hpf * v1[e] - v0[e]) * muv[e]; g[e] = g0[e] + (hpf * g1[e] - g0[e]) * mug[e];
                if (l > 0) v[e] = v[e] + (vf[e] - v[e]) * sigmoidf_(v0c[e] + lrv[e]);
                ssum += o[e]; }
            const float mean = red16(ssum) * (1.0f / 64.0f); float d[4], q = 0.f;
#pragma unroll
            for (int e = 0; e < 4; ++e) { d[e] = o[e] - mean; q += d[e] * d[e]; }
            const float rs = rsqrtf(red16(q) * (1.0f / 64.0f) + 64e-5f); float r[4];
#pragma unroll
            for (int e = 0; e < 4; ++e) r[e] = (d[e] * rs * lnw[e] + lnb[e] + bn * v[e]) * sigmoidf_(g[e]);
            v2u w; w.x = pk2h(r[0], r[1]); w.y = pk2h(r[2], r[3]); *(v2u*)(OUT + ch0) = w; }
        { const int h = hq, c0 = h * 128 + 8 * sub;
            float o[8], g[8]; unpk8(*(const v4u*)(O + 768 + c0), o); unpk8(*(const v4u*)(P + C_TG + c0), g);
            const f32x4 na = *(const f32x4*)(INF(I_RET_GN) + l * 512 + c0), nb = *(const f32x4*)(INF(I_RET_GN) + l * 512 + c0 + 4);
            float ssum = 0.f;
#pragma unroll
            for (int e = 0; e < 8; ++e) ssum += o[e];
            const float mean = red16(ssum) * (1.0f / 128.0f); float d[8], q = 0.f;
#pragma unroll
            for (int e = 0; e < 8; ++e) { d[e] = o[e] - mean; q += d[e] * d[e]; }
            const float rs = rsqrtf(red16(q) * (1.0f / 128.0f) + 1e-5f); float r[8];
#pragma unroll
            for (int e = 0; e < 8; ++e) r[e] = siluf_(g[e]) * d[e] * rs * (e < 4 ? na[e] : nb[e - 4]);
            v4u w; w.x = pk2h(r[0], r[1]); w.y = pk2h(r[2], r[3]); w.z = pk2h(r[4], r[5]); w.w = pk2h(r[6], r[7]); *(v4u*)(OUT + 768 + c0) = w; }
#pragma unroll
        for (int ps = 0; ps < 2; ++ps) { const int hr = 4 * ps + hq, h = hr < 6 ? hr : 5, c0 = h * 128 + 8 * sub;
            float o[8], z[8]; unpk8(*(const v4u*)(O + 1280 + c0), o); unpk8(*(const v4u*)(P + C_DZ + c0), z);
            const f32x4 na = *(const f32x4*)(INF(I_GDN_NW) + l * 768 + c0), nb = *(const f32x4*)(INF(I_GDN_NW) + l * 768 + c0 + 4);
            float q = 0.f;
#pragma unroll
            for (int e = 0; e < 8; ++e) q += o[e] * o[e];
            const float rs = rsqrtf(red16(q) * (1.0f / 128.0f) + 1e-6f); float r[8];
#pragma unroll
            for (int e = 0; e < 8; ++e) r[e] = o[e] * rs * (e < 4 ? na[e] : nb[e - 4]) * siluf_(z[e]);
            v4u w; w.x = pk2h(r[0], r[1]); w.y = pk2h(r[2], r[3]); w.z = pk2h(r[4], r[5]); w.w = pk2h(r[6], r[7]);
            if (hr < 6) *(v4u*)(OUT + 1280 + c0) = w; }
    }
}
#define XB_TMO      128
#define XB_XCNT(j)  (256  + 64 * (j))
#define XB_XSUB(j)  (1280 + 64 * (j))
#define XB_XGEN(j)  (2304 + 64 * (j))
#define XB_TOP      3328
#define XB_TOPGEN   3392
#define XCD_BAR_WORDS 3456
#define XB_SPIN_CAP (1u << 18)

__device__ __forceinline__ unsigned xb_ld(unsigned* p)              { return __hip_atomic_load(p, __ATOMIC_RELAXED, __HIP_MEMORY_SCOPE_AGENT); }
__device__ __forceinline__ unsigned xb_add(unsigned* p, unsigned v) { return __hip_atomic_fetch_add(p, v, __ATOMIC_RELAXED, __HIP_MEMORY_SCOPE_AGENT); }
__device__ __forceinline__ unsigned xb_xcc_id() { return (unsigned)__builtin_amdgcn_s_getreg((3 << 11) | 20) & 0xFu; }
#define XB_SPIN(cond, bar) do { unsigned _sp = 0; while (cond) { __builtin_amdgcn_s_sleep(1); \
    if ((++_sp & 255u) == 0u) { if (xb_ld(&(bar)[XB_TMO])) break; if (_sp > XB_SPIN_CAP) { atomicAdd(&(bar)[XB_TMO], 1u); break; } } } } while (0)

struct XcdBarrier {
    unsigned* bar; unsigned x;
    volatile LAS unsigned* st;
};

__device__ __forceinline__ XcdBarrier xcd_barrier_post(unsigned* bar, volatile LAS unsigned* st) {
    XcdBarrier b; b.bar = bar; b.x = xb_xcc_id(); b.st = st;
    if (otid() == 0) (void)xb_add(&bar[XB_XCNT(b.x)], 1u);
    return b;
}
__device__ __forceinline__ void xcd_barrier_complete(unsigned* bar, unsigned x, unsigned& nloc, unsigned& nx) {
    const unsigned G = gridDim.x * gridDim.y * gridDim.z;
    unsigned sum, cnt, mine, sp = 0u;
    for (;;) {
        sum = 0u; cnt = 0u; mine = 0u;
#pragma unroll
        for (unsigned j = 0; j < 16; ++j) { const unsigned c = xb_ld(&bar[XB_XCNT(j)]); sum += c; cnt += (c > 0u) ? 1u : 0u; mine = (j == x) ? c : mine; }
        if (sum == G) break;
        __builtin_amdgcn_s_sleep(1);
        if ((++sp & 255u) == 0u) { if (xb_ld(&bar[XB_TMO])) break; if (sp > XB_SPIN_CAP) { atomicAdd(&bar[XB_TMO], 1u); break; } }
    }
    nloc = mine > 0u ? mine : 1u; nx = cnt > 0u ? cnt : 1u;
}

__device__ __forceinline__ void xcd_barrier(const XcdBarrier& b) {
    asm volatile("s_waitcnt vmcnt(0)" ::: "memory");
    __syncthreads();
    if (otid() == 0) {
        unsigned* bar = b.bar;
        __builtin_amdgcn_s_waitcnt(0);
        unsigned nloc = b.st[0], nx = b.st[1];
        if (nloc == 0u) { xcd_barrier_complete(bar, b.x, nloc, nx); b.st[0] = nloc; b.st[1] = nx; }
        const unsigned old = xb_add(&bar[XB_XSUB(b.x)], 1u);
        const unsigned gen = old / nloc;
        if (old + 1u == (gen + 1u) * nloc) {
            __builtin_amdgcn_fence(__ATOMIC_RELEASE, "agent");
            asm volatile("s_waitcnt vmcnt(0)" ::: "memory");
            const unsigned og = xb_add(&bar[XB_TOP], 1u);
            const unsigned tg = og / nx;
            if (og + 1u == (tg + 1u) * nx) xb_add(&bar[XB_TOPGEN], 1u);
            else XB_SPIN(xb_ld(&bar[XB_TOPGEN]) == tg, bar);
            __builtin_amdgcn_fence(__ATOMIC_ACQUIRE, "agent");
            xb_add(&bar[XB_XGEN(b.x)], 1u);
            asm volatile("s_waitcnt vmcnt(0)" ::: "memory");
        } else {
            XB_SPIN(xb_ld(&bar[XB_XGEN(b.x)]) == gen, bar);
            __builtin_amdgcn_fence(__ATOMIC_ACQUIRE, "agent");
            asm volatile("s_waitcnt vmcnt(0)" ::: "memory");
        }
    }
    __syncthreads();
}

__device__ __forceinline__ void e1_tile(CArgs Ap, int l, int pm) {
    const bf16* PROJ = (const bf16*)(Ap->ws + WS_PROJ); bf16* __restrict__ A2 = (bf16*)(Ap->ws + WS_A2);
    const int tid = otid(), v = tid & 31, r0 = tid >> 5;
    int c1, c2; if (v < 12) { c1 = C_P1W + 8 * v; c2 = C_P2W + 8 * v; } else if (v < 24) { c1 = C_P1A + 8 * (v - 12); c2 = C_P2A + 8 * (v - 12); } else { c1 = C_P1V + 8 * (v - 24); c2 = C_P2V + 8 * (v - 24); }
    const bool is_w = v < 12, zero = (v >= 24) && (l == 0);
#pragma unroll
    for (int half = 0; half < 2; ++half) { v4u x1[8], x2[8];
#pragma unroll
        for (int k = 0; k < 8; ++k) { const int m = pm * 256 + r0 + 16 * (half * 8 + k); const bool hp = (m % SEQ) > 0;
            x1[k] = *(const v4u*)(PROJ + (size_t)m * NP + c1); x2[k] = *(const v4u*)(PROJ + (size_t)(hp ? m - 1 : m) * NP + c2); }
#pragma unroll
        for (int k = 0; k < 8; ++k) { const int m = pm * 256 + r0 + 16 * (half * 8 + k); const float hpf = ((m % SEQ) > 0) ? 1.f : 0.f;
            float a[8], b[8], o[8]; unpk8(x1[k], a); unpk8(x2[k], b);
#pragma unroll
            for (int e = 0; e < 8; ++e) { const float s = a[e] + hpf * b[e]; const float th = 1.0f - 2.0f * __builtin_amdgcn_rcpf(1.0f + __expf(2.0f * s)); o[e] = zero ? 0.f : (is_w ? th : s); }
            v4u w; w.x = pk2(o[0], o[1]); w.y = pk2(o[2], o[3]); w.z = pk2(o[4], o[5]); w.w = pk2(o[6], o[7]);
            *(v4u*)(A2 + (size_t)m * 256 + 8 * v) = w; } }
}

__global__ void __launch_bounds__(NTHR, 2) fwd_kernel(Args A_kernarg) {
    CArgs KA = (CArgs)__builtin_amdgcn_kernarg_segment_ptr();
    extern __shared__ __attribute__((aligned(16))) unsigned char lds_raw[];
    LAS unsigned char* lds0 = (LAS unsigned char*)lds_raw;
    const int tid = threadIdx.x;
    *(LAS int*)(size_t)tid_slot() = tid;
    if (tid < 4) ((LAS unsigned*)(lds0 + MISC_OFF))[tid] = 0u;
    __syncthreads();
#if !MK_SPLIT
    XcdBarrier bar = xcd_barrier_post((unsigned*)(KA->ws + WS_CTL) + CW_BAR, (volatile LAS unsigned*)(lds0 + MISC_OFF));
#define GRID_BAR() do { XcdBarrier b2_ = bar; asm volatile("" : "+s"(b2_.bar)); xcd_barrier(b2_); } while (0)
#else
#define GRID_BAR() do {} while (0)
#endif
#if MK_SPLIT
    const int lo = KA->ph_lo, hi = KA->ph_hi; int p = 0;
#define PH_IN (p >= lo && p < hi)
#define PH_NEXT (p + 1 < hi)
#define PH_INC ++p
#else
#define PH_IN true
#define PH_NEXT true
#define PH_INC do {} while (0)
#endif
#define PH_BEGIN if (PH_IN) { CArgs Ap = KA; asm volatile("" : "+s"(Ap)); unsigned char* ws = Ap->ws; LAS unsigned char* lds = lds0; \
        const int G = (int)gridDim.x, c = (int)blockIdx.x; LAS int* TOFF = (LAS int*)(lds + MISC_OFF + 64); (void)G; (void)c; (void)TOFF; (void)ws;
#define PH_END   if (PH_NEXT) { GRID_BAR(); } } PH_INC;
#define LAYER_BODY(l) \
        PH_BEGIN if (l == 0) { phase_convert<0>(Ap, 0, lds, c, G); phase_norm(Ap, 0, l); } else phase_norm(Ap, 1, l); __syncthreads(); PH_END \
        PH_BEGIN { pg8::Gemm g{(const bf16*)(ws + WS_H), (const bf16*)(ws + WS_WIN), NTOK, NP, DM}; unsigned* p1c = (unsigned*)(ws + WS_CTL) + CW_P1 + 64 * l; pg8::G1Order S{G, c, p1c}; \
            pg8::EpiBf16G1 E{(bf16*)(ws + WS_PROJ), NP}; \
            pg8::gemm_phase<pg8::EpiBf16G1, pg8::G1Order, true, true>(lds, g, S, E); \
            for (int uu = G - 1 - c; uu < 96; uu += G) {     \
                if (otid() == 0) { while (__hip_atomic_load(p1c, __ATOMIC_RELAXED, __HIP_MEMORY_SCOPE_AGENT) < 768u) __builtin_amdgcn_s_sleep(4); } \
                __syncthreads(); __builtin_amdgcn_fence(__ATOMIC_ACQUIRE, "agent"); \
                e1_tile(Ap, l, uu / 3); \
                asm volatile("s_waitcnt vmcnt(0)" ::: "memory"); __syncthreads(); __builtin_amdgcn_fence(__ATOMIC_ACQUIRE, "agent"); \
                int n3 = 3, k2 = 256; asm volatile("" : "+s"(n3), "+s"(k2)); pg8::Gemm g2{(const bf16*)(ws + WS_A2), (const bf16*)(ws + WS_LR2), NTOK, NLR, k2}; pg8::TriOrder S2{uu / 3, 3 * (uu % 3), n3}; \
                pg8::EpiBf16<0> E2{(bf16*)(ws + WS_LR), NLR, nullptr, 0, 0, 1.f}; \
                pg8::gemm_phase<pg8::EpiBf16<0>, pg8::TriOrder, true, PG8_SP2>(lds, g2, S2, E2); } } PH_END \
        PH_BEGIN phase_mixA(Ap, l, lds); PH_END \
        PH_BEGIN phase_mixB(Ap, l, lds); PH_END \
        PH_BEGIN phase_m2c(Ap, l); PH_END \
        PH_BEGIN { pg8::Gemm g{(const bf16*)(ws + WS_MIX), (const bf16*)(ws + WS_WOUT), NTOK, DM, DM}; pg8::StaticOrder S; S.init(NTOK, DM, G, c); \
            if (l == 0) { pg8::EpiResB16<true> E{(bf16*)(ws + WS_XBUF), Ap->in[I_X], DM}; pg8::gemm_phase<pg8::EpiResB16<true>, pg8::StaticOrder, true, true>(lds, g, S, E); } \
            else { pg8::EpiResB16<false> E{(bf16*)(ws + WS_XBUF), (const void*)(ws + WS_XBUF), DM}; pg8::gemm_phase<pg8::EpiResB16<false>, pg8::StaticOrder, true, true>(lds, g, S, E); } \
            phase_convert<1>(Ap, l, lds, c, G);     } PH_END \
        PH_BEGIN phase_r1(Ap, l, lds); PH_END \
        PH_BEGIN { compute_toff(Ap, l, lds, 0); g3_rowtok(Ap, l, lds, c);     \
            pg8::Gemm g{(const bf16*)(ws + WS_H), (const bf16*)(ws + WS_W13), MAXROWS, 512, DM}; pg8::GroupOrder<1> S{TOFF, G, c};     \
            pg8::EpiSwiGLU E{(bf16*)(ws + WS_HID), 256}; \
            pg8::gemm_phase_ga<pg8::EpiSwiGLU, pg8::GroupOrder<1>, true, true>(lds, g, S, E, (const PG8_LAS int*)(lds + RT_OFF)); \
            if (l == 0) {     \
                const int nun = 2 * __builtin_amdgcn_readfirstlane(TOFF[32]), nidle = G - nun; const bool split = nidle >= 32; \
                if (!split || c >= nun) { __syncthreads(); phase_convert<0>(Ap, 1, lds, split ? c - nun : c, split ? nidle : G); } } } PH_END \
        PH_BEGIN {     \
            pg8::Gemm g{(const bf16*)(ws + WS_HID), (const bf16*)(ws + WS_W2X), MAXROWS, DM, 256}; pg8::GroupOrder<3> S{TOFF, G, c}; \
            pg8::EpiBf16Grp E{(bf16*)(ws + WS_YS), DM, 7}; \
            pg8::gemm_phase<pg8::EpiBf16Grp, pg8::GroupOrder<3>, true, PG8_SP2>(lds, g, S, E); } PH_END
    LAYER_BODY(0)
    LAYER_BODY(1)
    if (PH_IN) { CArgs Ap = KA; asm volatile("" : "+s"(Ap)); phase_norm(Ap, 2, 0); }
}
constexpr int NPHASES = 19;

extern "C" void kernel_launch(void* const* d_in, const int* in_sizes, int n_in, void* d_out, int out_size, void* d_ws, size_t ws_size, hipStream_t stream) {
    static int grid = 0;
    if (grid == 0) {
        if (n_in != 36 || out_size != NTOK * DM || ws_size < WS_END) { fprintf(stderr, "kernel_launch: unexpected shapes (n_in %d, out %d, ws %zu, need %zu)\n", n_in, out_size, ws_size, (size_t)WS_END); grid = -1; return; }
        int dev = 0, cus = 0, per_cu = 0;
        if (hipGetDevice(&dev) != hipSuccess || hipDeviceGetAttribute(&cus, hipDeviceAttributeMultiprocessorCount, dev) != hipSuccess) { grid = -1; return; }
        if (hipFuncSetAttribute((const void*)fwd_kernel, hipFuncAttributeMaxDynamicSharedMemorySize, LDS_BYTES) != hipSuccess) { fprintf(stderr, "kernel_launch: hipFuncSetAttribute failed\n"); grid = -1; return; }
        if (hipOccupancyMaxActiveBlocksPerMultiprocessor(&per_cu, (const void*)fwd_kernel, NTHR, LDS_BYTES) != hipSuccess || per_cu < 1) { fprintf(stderr, "kernel_launch: occupancy query says %d\n", per_cu); }
        (void)hipGetLastError();
        if (cus < 192) { fprintf(stderr, "kernel_launch: %d CUs (the gathered MoE up GEMM needs one unit per workgroup: >= 192)\n", cus); grid = -1; return; }
        grid = cus;
    }
    if (grid < 0) return;
    if (hipMemsetAsync((char*)d_ws + WS_CTL, 0, 32768, stream) != hipSuccess) return;
    Args a{};
    for (int i = 0; i < 36; ++i) a.in[i] = d_in[i];
    a.out = (float*)d_out; a.ws = (unsigned char*)d_ws;
#if MK_SPLIT
    for (int p = 0; p < NPHASES; ++p) { a.ph_lo = p; a.ph_hi = p + 1; hipLaunchKernelGGL(fwd_kernel, dim3(grid), dim3(NTHR), LDS_BYTES, stream, a); }
#else
    a.ph_lo = 0; a.ph_hi = NPHASES;
    hipLaunchKernelGGL(fwd_kernel, dim3(grid), dim3(NTHR), LDS_BYTES, stream, a);
#endif
}
```
